# Optimizing an MI355X kernel written in HIP

```python
import jax, jax.numpy as jnp
from jax import lax
import numpy as np

D_MODEL = 1024
BATCH = 2
SEQ = 8192
DEPTH = 4

GRID_W = 64
HEAD_DIM = 64
N_HEADS = 12
N_KV_HEADS = 4
Q_GROUP = N_HEADS // N_KV_HEADS
N_FOURIER_GROUPS = 4
FOURIER_GROUP_W = 64
Q_W = N_HEADS * HEAD_DIM
KV_W = N_KV_HEADS * HEAD_DIM
F_W = N_FOURIER_GROUPS * FOURIER_GROUP_W
N_BRANCHES = 2
GATE_W = N_BRANCHES * D_MODEL
IN_W = Q_W + 2 * KV_W + F_W + GATE_W
D_FF = 4 * D_MODEL
Q_BLOCK = 128
ROPE_THETA = 10000.0
ROPE_PAIRS_PER_AXIS = HEAD_DIM // 4
EPS = 1e-6

kernel_name = "hybrid_gqa_axial_rope_fnet_gated_encoder"


def rmsnorm(x, g):
    xf = x.astype(jnp.float32)
    y = xf * lax.rsqrt(jnp.mean(xf * xf, axis=-1, keepdims=True) + EPS)
    return (y * g.astype(jnp.float32)).astype(x.dtype)


def axial_rope_tables(seq_len):
    n_rows = seq_len // GRID_W
    rows = jnp.repeat(jnp.arange(n_rows, dtype=jnp.float32), GRID_W)
    cols = jnp.tile(jnp.arange(GRID_W, dtype=jnp.float32), n_rows)
    inv_freq = ROPE_THETA ** (-jnp.arange(ROPE_PAIRS_PER_AXIS, dtype=jnp.float32) / ROPE_PAIRS_PER_AXIS)
    ang = jnp.concatenate([rows[:, None] * inv_freq[None, :],
                           cols[:, None] * inv_freq[None, :]], axis=-1)
    return jnp.cos(ang), jnp.sin(ang)


def apply_rope(x, cos, sin):
    xp = x.reshape(*x.shape[:-1], HEAD_DIM // 2, 2)
    x0, x1 = xp[..., 0], xp[..., 1]
    c = cos[None, :, None, :].astype(x.dtype)
    s = sin[None, :, None, :].astype(x.dtype)
    return jnp.stack([x0 * c - x1 * s, x0 * s + x1 * c], axis=-1).reshape(x.shape)


def blocked_gqa(q, k, v):
    B, S, _, _ = q.shape
    n_blk = S // Q_BLOCK
    scale = HEAD_DIM ** -0.5
    qg = q.reshape(B, n_blk, Q_BLOCK, N_KV_HEADS, Q_GROUP, HEAD_DIM)
    qg = jnp.transpose(qg, (1, 0, 3, 4, 2, 5))
    kt = jnp.transpose(k, (0, 2, 1, 3))
    vt = jnp.transpose(v, (0, 2, 1, 3))

    def one_block(qb):
        s = jnp.einsum('bkgqd,bksd->bkgqs', qb, kt, preferred_element_type=jnp.float32) * scale
        p = jax.nn.softmax(s, axis=-1)
        return jnp.einsum('bkgqs,bksd->bkgqd', p.astype(vt.dtype), vt)

    o = lax.map(one_block, qg)
    o = jnp.transpose(o, (1, 0, 4, 2, 3, 5))
    return o.reshape(B, S, Q_W)


def fourier_mix(f):
    B, S, _ = f.shape
    fg = f.reshape(B, S, N_FOURIER_GROUPS, FOURIER_GROUP_W).astype(jnp.float32)
    out = jnp.fft.fft2(fg, axes=(1, 3), norm="ortho").real
    return out.reshape(B, S, F_W).astype(f.dtype)


def mixer_block(h, w_in, b_gate, q_gain, k_gain, w_attn_branch, w_fourier_branch, w_out, cos, sin):
    B, S, _ = h.shape
    proj = h @ w_in
    q, k, v, f, gate_logits = jnp.split(
        proj, [Q_W, Q_W + KV_W, Q_W + 2 * KV_W, Q_W + 2 * KV_W + F_W], axis=-1)
    q = apply_rope(rmsnorm(q.reshape(B, S, N_HEADS, HEAD_DIM), q_gain), cos, sin)
    k = apply_rope(rmsnorm(k.reshape(B, S, N_KV_HEADS, HEAD_DIM), k_gain), cos, sin)
    v = v.reshape(B, S, N_KV_HEADS, HEAD_DIM)
    attn = blocked_gqa(q, k, v)
    four = fourier_mix(f)
    gates = jax.nn.sigmoid((gate_logits + b_gate).astype(jnp.float32)).astype(h.dtype)
    g_attn, g_four = jnp.split(gates, N_BRANCHES, axis=-1)
    merged = g_attn * (attn @ w_attn_branch) + g_four * (four @ w_fourier_branch)
    return merged @ w_out


def squared_relu_mlp(h, w_up, w_down):
    u = jax.nn.relu(h @ w_up)
    return (u * u) @ w_down


def setup_inputs(seed: int = 0) -> dict:
    key = jax.random.key(seed)
    ks = jax.random.split(key, 13)
    f32 = jnp.float32

    def nrm(k, shape, fan_in):
        return jax.random.normal(k, shape, f32) * (fan_in ** -0.5)

    def gain(k, shape):
        return 1.0 + 0.02 * jax.random.normal(k, shape, f32)

    return {
        "x": jax.random.normal(ks[0], (BATCH, SEQ, D_MODEL), f32),
        "norm_mix": gain(ks[1], (DEPTH, D_MODEL)),
        "w_in": nrm(ks[2], (DEPTH, D_MODEL, IN_W), D_MODEL),
        "b_gate": 0.01 * jax.random.normal(ks[3], (DEPTH, GATE_W), f32),
        "q_gain": gain(ks[4], (DEPTH, HEAD_DIM)),
        "k_gain": gain(ks[5], (DEPTH, HEAD_DIM)),
        "w_attn_branch": nrm(ks[6], (DEPTH, Q_W, D_MODEL), Q_W),
        "w_fourier_branch": nrm(ks[7], (DEPTH, F_W, D_MODEL), F_W),
        "w_out": nrm(ks[8], (DEPTH, D_MODEL, D_MODEL), D_MODEL),
        "norm_mlp": gain(ks[9], (DEPTH, D_MODEL)),
        "w_up": nrm(ks[10], (DEPTH, D_MODEL, D_FF), D_MODEL),
        "w_down": nrm(ks[11], (DEPTH, D_FF, D_MODEL), D_FF),
        "norm_final": gain(ks[12], (D_MODEL,)),
    }


def reference(x, norm_mix, w_in, b_gate, q_gain, k_gain, w_attn_branch, w_fourier_branch,
              w_out, norm_mlp, w_up, w_down, norm_final):
    cos, sin = axial_rope_tables(x.shape[1])
    for l in range(DEPTH):
        h = rmsnorm(x, norm_mix[l])
        x = x + mixer_block(h, w_in[l], b_gate[l], q_gain[l], k_gain[l], w_attn_branch[l],
                            w_fourier_branch[l], w_out[l], cos, sin)
        h = rmsnorm(x, norm_mlp[l])
        x = x + squared_relu_mlp(h, w_up[l], w_down[l])
    return rmsnorm(x, norm_final)
```

```cpp
#include <hip/hip_runtime.h>
#include <hip/hip_cooperative_groups.h>
#include <cstdio>
#include <cstdint>
namespace cg = cooperative_groups;
namespace pg8 {
#define PG8_LAS __attribute__((address_space(3)))
typedef unsigned short bf16_t;
typedef short bf16x8 __attribute__((ext_vector_type(8)));
typedef float f32x4 __attribute__((ext_vector_type(4)));
typedef unsigned u32x4 __attribute__((ext_vector_type(4)));
constexpr int BM = 256, BK = 64, HALF = 128, HTB = HALF * BK * 2  , STAGE_BYTES = 8 * HTB, NXCD = 8, WGM = 8;

__host__ __device__ __forceinline__ int lds_byte(int r, int c) { const int st = (r >> 4) * 2 + (c >> 5), rr = r & 15, cc = c & 31, ob = rr * 64 + cc * 2; return st * 1024 + (ob ^ (((ob >> 9) & 1) << 5)); }
__host__ __device__ __forceinline__ void stage_rc(int b, int& R, int& C) { const int st = b / 1024, sb = b % 1024, swz = sb ^ (((sb >> 9) & 1) << 5); R = (st >> 1) * 16 + swz / 64; C = (st & 1) * 32 + (swz % 64) / 2; }
__host__ __device__ __forceinline__ int perm32(int rho) { const int n = rho >> 4, i = rho & 15; return 8 * (i >> 2) + 4 * n + (i & 3); }

struct Unit { int pm, pn; };
struct Gemm { const bf16_t* A; const bf16_t* Bt; int M, N, K, lda, ldb; };

struct StaticOrder {
    int nM, nN, nwg, G, c;
    __host__ __device__ void init(int M, int N, int G_, int c_) { nM = M / BM; nN = N / BM; nwg = nM * nN; G = G_; c = c_; }
    __host__ __device__ bool next(int i, Unit& u) const {
        const long L = (long)i * G + c; if (L >= nwg) return false;
        int wgid = (int)L; { const int q = nwg / NXCD, r = nwg % NXCD, xcd = wgid % NXCD, off = wgid / NXCD; wgid = (xcd < r ? xcd * (q + 1) : r * (q + 1) + (xcd - r) * q) + off; }
        const int nig = WGM * nN, gid = wgid / nig, fm = gid * WGM, gsz = (nM - fm) < WGM ? (nM - fm) : WGM;
        u.pm = fm + ((wgid % nig) % gsz); u.pn = (wgid % nig) / gsz; return true;
    }
    __device__ __forceinline__ void a_ready(const Unit&) const {}
    __device__ __forceinline__ void done(const Unit&) const {}
};
typedef float f32x2_cv __attribute__((ext_vector_type(2))); typedef __bf16 bf16x2_cv __attribute__((ext_vector_type(2)));
__device__ __forceinline__ unsigned cvt_pk_bf16(float lo, float hi) { f32x2_cv v = {lo, hi}; bf16x2_cv b = __builtin_convertvector(v, bf16x2_cv); return __builtin_bit_cast(unsigned, b); }
typedef float f32x2 __attribute__((ext_vector_type(2)));
typedef PG8_LAS float PG8_LAS_F;
constexpr float RMS_EPS = 1e-6f;
constexpr float ATT_C2 = 0.125f * 1.4426950408889634f;
__device__ __forceinline__ float bf_lo(unsigned w) { return __uint_as_float(w << 16); }
__device__ __forceinline__ float bf_hi(unsigned w) { return __uint_as_float(w & 0xffff0000u); }
__device__ __forceinline__ u32x4 pack8(const f32x4 a, const f32x4 b) { u32x4 w; w.x = cvt_pk_bf16(a[0], a[1]); w.y = cvt_pk_bf16(a[2], a[3]); w.z = cvt_pk_bf16(b[0], b[1]); w.w = cvt_pk_bf16(b[2], b[3]); return w; }
__device__ __forceinline__ float hsum4(const f32x4 a) { return (a[0] + a[1]) + (a[2] + a[3]); }
__device__ __forceinline__ float row_rstd(const float* ss, int row) {
    const f32x4* p = (const f32x4*)(ss + (size_t)row * 16);
    const float s = (hsum4(p[0]) + hsum4(p[1])) + (hsum4(p[2]) + hsum4(p[3]));
    return rsqrtf(s * (1.0f / 1024.0f) + RMS_EPS);
}
__device__ __forceinline__ void rows_scale(const PG8_LAS float* rl, const float* ss, int row0, int lrow, float (&rs)[2][4]) {
    if (rl) {
#pragma unroll
        for (int ai = 0; ai < 2; ++ai)
#pragma unroll
            for (int m = 0; m < 4; ++m) rs[ai][m] = rl[ai * HALF + m * 16 + lrow];
    } else {
#pragma unroll
        for (int ai = 0; ai < 2; ++ai)
#pragma unroll
            for (int m = 0; m < 4; ++m) rs[ai][m] = row_rstd(ss, row0 + ai * HALF + m * 16);
    }
}
struct EpiInProj {
    static constexpr bool PERM = true, AFTER_DRAIN = false; static constexpr int MIDT = 0;
    const float* ss; bf16_t *Q, *Kb, *Vb, *Fb, *G; const float *qg, *kg, *bgate; const PG8_LAS float* rl;
    __device__ __forceinline__ void operator()(const f32x4 (&acc)[2][2][4][2], const Unit& u, int wr, int wc, int fr, int fq) const {
        const int pn = u.pn; int row0 = u.pm * BM + wr * 64 + fr; asm volatile("" : "+v"(row0));
        float rsv[2][4]; rows_scale(rl, ss, row0, wr * 64 + fr, rsv);
        if (pn < 4) {
            const float* gp = (pn < 3) ? qg : kg;
            int fqo = fq; asm volatile("" : "+v"(fqo));
            float ifr[4];
#pragma unroll
            for (int j = 0; j < 4; ++j) ifr[j] = __builtin_amdgcn_exp2f(-(float)(4 * fqo + j) * (13.287712379549449f / 16.0f)) * 0.15915494309189535f;
            const float osc = (pn < 3) ? ATT_C2 : 1.0f;
            bf16_t* dst = (pn < 3) ? Q + (4 * pn + wc) * 64 : Kb + wc * 64; const int pitch = (pn < 3) ? 768 : 256;
#pragma unroll
            for (int ai = 0; ai < 2; ++ai)
#pragma unroll
                for (int m = 0; m < 4; ++m) {
                    const int row = row0 + ai * HALF + m * 16; const float rs = rsv[ai][m];
                    const int t = row & 8191; const float prow = (float)(t >> 6), pcol = (float)(t & 63);
                    float q = 0.f;
#pragma unroll
                    for (int bj = 0; bj < 2; ++bj)
#pragma unroll
                        for (int n = 0; n < 2; ++n) q += hsum4(acc[ai][bj][m][n] * acc[ai][bj][m][n]);
                    q += __shfl_xor(q, 16); q += __shfl_xor(q, 32);
                    const float hr = rs * rsqrtf(q * rs * rs * (1.0f / 64.0f) + RMS_EPS) * osc;
#pragma unroll
                    for (int bj = 0; bj < 2; ++bj) {
                        const float pos = bj ? pcol : prow; f32x4 o[2];
#pragma unroll
                        for (int n = 0; n < 2; ++n) {
                            const f32x4 gvv = *(const f32x4*)(gp + 32 * bj + 8 * fq + 4 * n); const f32x4 xv = acc[ai][bj][m][n] * hr * gvv;
#pragma unroll
                            for (int e = 0; e < 2; ++e) {
                                const float rev = pos * ifr[2 * n + e];
                                const float c = __builtin_amdgcn_cosf(rev), s = __builtin_amdgcn_sinf(rev);
                                o[n][2 * e] = xv[2 * e] * c - xv[2 * e + 1] * s; o[n][2 * e + 1] = xv[2 * e] * s + xv[2 * e + 1] * c;
                            }
                        }
                        *(u32x4*)(dst + (size_t)row * pitch + 32 * bj + 8 * fq) = pack8(o[0], o[1]);
                    }
                    asm volatile("" ::: "memory");
                }
        } else if (pn < 6) {
            bf16_t* dst = (pn == 4) ? Vb : Fb;
#pragma unroll
            for (int ai = 0; ai < 2; ++ai)
#pragma unroll
                for (int m = 0; m < 4; ++m) {
                    const int row = row0 + ai * HALF + m * 16; const float rs = rsv[ai][m];
#pragma unroll
                    for (int bj = 0; bj < 2; ++bj) *(u32x4*)(dst + (size_t)row * 256 + 128 * bj + 32 * wc + 8 * fq) = pack8(acc[ai][bj][m][0] * rs, acc[ai][bj][m][1] * rs);
                    asm volatile("" ::: "memory");
                }
        } else {
            int gc0 = (pn - 6) * 256 + 32 * wc + 8 * fq; asm volatile("" : "+v"(gc0));
            f32x4 bv[2][2];
#pragma unroll
            for (int bj = 0; bj < 2; ++bj)
#pragma unroll
                for (int n = 0; n < 2; ++n) bv[bj][n] = *(const f32x4*)(bgate + gc0 + 128 * bj + 4 * n);
#pragma unroll
            for (int ai = 0; ai < 2; ++ai)
#pragma unroll
                for (int m = 0; m < 4; ++m) {
                    const int row = row0 + ai * HALF + m * 16; const float rs = rsv[ai][m];
#pragma unroll
                    for (int bj = 0; bj < 2; ++bj) { f32x4 o[2];
#pragma unroll
                        for (int n = 0; n < 2; ++n) { const f32x4 x = acc[ai][bj][m][n] * rs + bv[bj][n];
#pragma unroll
                            for (int e = 0; e < 4; ++e) o[n][e] = __builtin_amdgcn_rcpf(1.0f + __builtin_amdgcn_exp2f(-1.4426950408889634f * x[e])); }
                        *(u32x4*)(G + (size_t)row * 2048 + gc0 + 128 * bj) = pack8(o[0], o[1]); }
                    asm volatile("" ::: "memory");
                }
        }
    }
};
template <int MODE> struct EpiBranch {
    static constexpr bool PERM = true, AFTER_DRAIN = false; static constexpr int MIDT = 0;
    const bf16_t* G; bf16_t* MG;
    __device__ __forceinline__ void operator()(const f32x4 (&acc)[2][2][4][2], const Unit& u, int wr, int wc, int fr, int fq) const {
        int row0 = u.pm * BM + wr * 64 + fr, col0 = u.pn * BM + 32 * wc + 8 * fq; asm volatile("" : "+v"(row0), "+v"(col0));
#pragma unroll
        for (int ai = 0; ai < 2; ++ai)
#pragma unroll
            for (int m = 0; m < 4; ++m) {
                const int row = row0 + ai * HALF + m * 16;
#pragma unroll
                for (int bj = 0; bj < 2; ++bj) {
                    const int col = col0 + 128 * bj;
                    const u32x4 gw = *(const u32x4*)(G + (size_t)row * 2048 + (MODE == 0 ? 1024 : 0) + col);
                    f32x4 o0, o1; const f32x4 a0 = acc[ai][bj][m][0], a1 = acc[ai][bj][m][1];
                    o0[0] = bf_lo(gw.x) * a0[0]; o0[1] = bf_hi(gw.x) * a0[1]; o0[2] = bf_lo(gw.y) * a0[2]; o0[3] = bf_hi(gw.y) * a0[3];
                    o1[0] = bf_lo(gw.z) * a1[0]; o1[1] = bf_hi(gw.z) * a1[1]; o1[2] = bf_lo(gw.w) * a1[2]; o1[3] = bf_hi(gw.w) * a1[3];
                    bf16_t* p = MG + (size_t)row * 1024 + col;
                    if (MODE == 1) { const u32x4 tw = *(const u32x4*)p;
                        o0[0] += bf_lo(tw.x); o0[1] += bf_hi(tw.x); o0[2] += bf_lo(tw.y); o0[3] += bf_hi(tw.y);
                        o1[0] += bf_lo(tw.z); o1[1] += bf_hi(tw.z); o1[2] += bf_lo(tw.w); o1[3] += bf_hi(tw.w); }
                    *(u32x4*)p = pack8(o0, o1);
                }
                asm volatile("" ::: "memory");
            }
    }
};
struct EpiBranchZ {
    static constexpr bool PERM = true, AFTER_DRAIN = false; static constexpr int MIDT = 12;
    const bf16_t* G; bf16_t* MG;
    __device__ __forceinline__ void mid(f32x4 (&acc)[2][2][4][2], const Unit& u, int wr, int wc, int fr, int fq) const {
        int row0 = u.pm * BM + wr * 64 + fr, col0 = u.pn * BM + 32 * wc + 8 * fq; asm volatile("" : "+v"(row0), "+v"(col0));
#pragma unroll
        for (int ai = 0; ai < 2; ++ai)
#pragma unroll
            for (int m = 0; m < 4; ++m) {
                const int row = row0 + ai * HALF + m * 16;
#pragma unroll
                for (int bj = 0; bj < 2; ++bj) {
                    const bf16_t* gp = G + (size_t)row * 2048 + col0 + 128 * bj;
                    const u32x4 ga = *(const u32x4*)gp, gf = *(const u32x4*)(gp + 1024);
                    f32x4& a0 = acc[ai][bj][m][0]; f32x4& a1 = acc[ai][bj][m][1];
#define BZ_R(A, F) ((A) * __builtin_amdgcn_rcpf(fmaxf((F), 1e-6f)))
                    a0[0] *= BZ_R(bf_lo(ga.x), bf_lo(gf.x)); a0[1] *= BZ_R(bf_hi(ga.x), bf_hi(gf.x)); a0[2] *= BZ_R(bf_lo(ga.y), bf_lo(gf.y)); a0[3] *= BZ_R(bf_hi(ga.y), bf_hi(gf.y));
                    a1[0] *= BZ_R(bf_lo(ga.z), bf_lo(gf.z)); a1[1] *= BZ_R(bf_hi(ga.z), bf_hi(gf.z)); a1[2] *= BZ_R(bf_lo(ga.w), bf_lo(gf.w)); a1[3] *= BZ_R(bf_hi(ga.w), bf_hi(gf.w));
#undef BZ_R
                }
                asm volatile("" ::: "memory");
            }
    }
    __device__ __forceinline__ void operator()(f32x4 (&acc)[2][2][4][2], const Unit& u, int wr, int wc, int fr, int fq) const {
        int row0 = u.pm * BM + wr * 64 + fr, col0 = u.pn * BM + 32 * wc + 8 * fq; asm volatile("" : "+v"(row0), "+v"(col0));
#pragma unroll
        for (int ai = 0; ai < 2; ++ai)
#pragma unroll
            for (int m = 0; m < 4; ++m) {
                int rb = row0 + ai * HALF + m * 16; asm volatile("" : "+v"(rb));
                const bf16_t* gp = G + (size_t)rb * 2048 + 1024 + col0;
                const u32x4 g0 = *(const u32x4*)gp, g1 = *(const u32x4*)(gp + 128);
#define BZ_M(A, GW) { f32x4& a0 = A[0]; f32x4& a1 = A[1]; a0[0] *= fmaxf(bf_lo(GW.x), 1e-6f); a0[1] *= fmaxf(bf_hi(GW.x), 1e-6f); a0[2] *= fmaxf(bf_lo(GW.y), 1e-6f); a0[3] *= fmaxf(bf_hi(GW.y), 1e-6f); \
                      a1[0] *= fmaxf(bf_lo(GW.z), 1e-6f); a1[1] *= fmaxf(bf_hi(GW.z), 1e-6f); a1[2] *= fmaxf(bf_lo(GW.w), 1e-6f); a1[3] *= fmaxf(bf_hi(GW.w), 1e-6f); }
                BZ_M(acc[ai][0][m], g0) BZ_M(acc[ai][1][m], g1)
#undef BZ_M
                asm volatile("" : "+v"(acc[ai][0][m][0]), "+v"(acc[ai][0][m][1]), "+v"(acc[ai][1][m][0]), "+v"(acc[ai][1][m][1]) :: "memory");
            }
#pragma unroll
        for (int ai = 0; ai < 2; ++ai)
#pragma unroll
            for (int m = 0; m < 4; ++m) {
                int row = row0 + ai * HALF + m * 16; asm volatile("" : "+v"(row));
                bf16_t* p = MG + (size_t)row * 1024 + col0;
                *(u32x4*)p = pack8(acc[ai][0][m][0], acc[ai][0][m][1]); *(u32x4*)(p + 128) = pack8(acc[ai][1][m][0], acc[ai][1][m][1]);
            }
    }
};
struct EpiRes {
    static constexpr bool PERM = true, AFTER_DRAIN = false; static constexpr int MIDT = 0;
    bf16_t* xb; float* ss;
    __device__ __forceinline__ void operator()(f32x4 (&acc)[2][2][4][2], const Unit& u, int wr, int wc, int fr, int fq) const {
        int row0 = u.pm * BM + wr * 64 + fr, col0 = u.pn * BM + 32 * wc + 8 * fq; asm volatile("" : "+v"(row0), "+v"(col0));
#pragma unroll
        for (int ai = 0; ai < 2; ++ai)
#pragma unroll
          for (int m = 0; m < 4; ++m) {
            int rb = row0 + ai * HALF + 16 * m; asm volatile("" : "+v"(rb));
            const bf16_t* p = xb + (size_t)rb * 1024 + col0;
            const u32x4 b0 = *(const u32x4*)p, b1 = *(const u32x4*)(p + 128);
            f32x4& a00 = acc[ai][0][m][0]; f32x4& a01 = acc[ai][0][m][1]; f32x4& a10 = acc[ai][1][m][0]; f32x4& a11 = acc[ai][1][m][1];
            a00[0] += bf_lo(b0.x); a00[1] += bf_hi(b0.x); a00[2] += bf_lo(b0.y); a00[3] += bf_hi(b0.y); a01[0] += bf_lo(b0.z); a01[1] += bf_hi(b0.z); a01[2] += bf_lo(b0.w); a01[3] += bf_hi(b0.w);
            a10[0] += bf_lo(b1.x); a10[1] += bf_hi(b1.x); a10[2] += bf_lo(b1.y); a10[3] += bf_hi(b1.y); a11[0] += bf_lo(b1.z); a11[1] += bf_hi(b1.z); a11[2] += bf_lo(b1.w); a11[3] += bf_hi(b1.w);
            asm volatile("" : "+v"(acc[ai][0][m][0]), "+v"(acc[ai][0][m][1]), "+v"(acc[ai][1][m][0]), "+v"(acc[ai][1][m][1]) :: "memory"); }
#pragma unroll
        for (int ai = 0; ai < 2; ++ai)
#pragma unroll
            for (int m = 0; m < 4; ++m) {
                int row = row0 + ai * HALF + m * 16; asm volatile("" : "+v"(row)); float q = 0.f;
                bf16_t* pb = xb + (size_t)row * 1024 + col0;
#pragma unroll
                for (int bj = 0; bj < 2; ++bj) {
                    const f32x4 o0 = acc[ai][bj][m][0], o1 = acc[ai][bj][m][1];
                    *(u32x4*)(pb + 128 * bj) = pack8(o0, o1);
                    q += hsum4(o0 * o0) + hsum4(o1 * o1);
                }
                q += __shfl_xor(q, 16); q += __shfl_xor(q, 32);
                if (fq == 0) ss[(size_t)row * 16 + 4 * u.pn + wc] = q;
                asm volatile("" ::: "memory");
            }
    }
};
struct EpiResFinal {
    static constexpr bool PERM = true, AFTER_DRAIN = false; static constexpr int MIDT = 0;
    const bf16_t* xb; float* ss; float* out; const float* gfin; unsigned* gcnt; PG8_LAS float* tab;
    __device__ __forceinline__ void operator()(f32x4 (&acc)[2][2][4][2], const Unit& u, int wr, int wc, int fr, int fq) const {
        int row0 = u.pm * BM + wr * 64 + fr, col0 = u.pn * BM + 32 * wc + 8 * fq; asm volatile("" : "+v"(row0), "+v"(col0));
#pragma unroll
        for (int ai = 0; ai < 2; ++ai)
#pragma unroll
          for (int m = 0; m < 4; ++m) {
            int rb = row0 + ai * HALF + 16 * m; asm volatile("" : "+v"(rb));
            const bf16_t* p = xb + (size_t)rb * 1024 + col0;
            const u32x4 b0 = *(const u32x4*)p, b1 = *(const u32x4*)(p + 128);
            f32x4& a00 = acc[ai][0][m][0]; f32x4& a01 = acc[ai][0][m][1]; f32x4& a10 = acc[ai][1][m][0]; f32x4& a11 = acc[ai][1][m][1];
            a00[0] += bf_lo(b0.x); a00[1] += bf_hi(b0.x); a00[2] += bf_lo(b0.y); a00[3] += bf_hi(b0.y); a01[0] += bf_lo(b0.z); a01[1] += bf_hi(b0.z); a01[2] += bf_lo(b0.w); a01[3] += bf_hi(b0.w);
            a10[0] += bf_lo(b1.x); a10[1] += bf_hi(b1.x); a10[2] += bf_lo(b1.y); a10[3] += bf_hi(b1.y); a11[0] += bf_lo(b1.z); a11[1] += bf_hi(b1.z); a11[2] += bf_lo(b1.w); a11[3] += bf_hi(b1.w);
            asm volatile("" : "+v"(acc[ai][0][m][0]), "+v"(acc[ai][0][m][1]), "+v"(acc[ai][1][m][0]), "+v"(acc[ai][1][m][1]) :: "memory"); }
#pragma unroll
        for (int ai = 0; ai < 2; ++ai)
#pragma unroll
            for (int m = 0; m < 4; ++m) {
                int row = row0 + ai * HALF + m * 16; asm volatile("" : "+v"(row)); float q = 0.f;
#pragma unroll
                for (int bj = 0; bj < 2; ++bj) q += hsum4(acc[ai][bj][m][0] * acc[ai][bj][m][0]) + hsum4(acc[ai][bj][m][1] * acc[ai][bj][m][1]);
                q += __shfl_xor(q, 16); q += __shfl_xor(q, 32);
                if (fq == 0) ss[(size_t)row * 16 + 4 * u.pn + wc] = q;
            }
        asm volatile("s_waitcnt vmcnt(0)" ::: "memory");
        __syncthreads();
        if (threadIdx.x == 0) {
            __builtin_amdgcn_fence(__ATOMIC_RELEASE, "agent"); asm volatile("s_waitcnt vmcnt(0)" ::: "memory");
            const unsigned old = __hip_atomic_fetch_add(gcnt, 1u, __ATOMIC_RELAXED, __HIP_MEMORY_SCOPE_AGENT), target = (old / 4u + 1u) * 4u; unsigned sp = 0;
            while (__hip_atomic_load(gcnt, __ATOMIC_RELAXED, __HIP_MEMORY_SCOPE_AGENT) < target) { __builtin_amdgcn_s_sleep(1); if (++sp > (1u << 24)) break; }
            __builtin_amdgcn_fence(__ATOMIC_ACQUIRE, "agent"); asm volatile("s_waitcnt vmcnt(0)" ::: "memory");
        }
        __syncthreads();
        if (threadIdx.x < 256) tab[threadIdx.x] = row_rstd(ss, u.pm * BM + (int)threadIdx.x);
        __syncthreads();
        float rsv[2][4];
#pragma unroll
        for (int ai = 0; ai < 2; ++ai)
#pragma unroll
            for (int m = 0; m < 4; ++m) rsv[ai][m] = tab[ai * HALF + wr * 64 + m * 16 + fr];
        f32x4 gv[2][2];
#pragma unroll
        for (int bj = 0; bj < 2; ++bj)
#pragma unroll
            for (int n = 0; n < 2; ++n) { gv[bj][n] = *(const f32x4*)(gfin + col0 + 128 * bj + 4 * n); asm volatile("" : "+v"(gv[bj][n])); }
        asm volatile("" ::: "memory");
#pragma unroll
        for (int ai = 0; ai < 2; ++ai)
#pragma unroll
            for (int m = 0; m < 4; ++m) {
                int row = row0 + ai * HALF + m * 16; asm volatile("" : "+v"(row)); const float rs = rsv[ai][m];
                float* po = out + (size_t)row * 1024 + col0;
#pragma unroll
                for (int bj = 0; bj < 2; ++bj) { *(f32x4*)(po + 128 * bj) = acc[ai][bj][m][0] * rs * gv[bj][0]; *(f32x4*)(po + 128 * bj + 4) = acc[ai][bj][m][1] * rs * gv[bj][1]; }
            }
    }
};
struct EpiUp {
    static constexpr bool PERM = true, AFTER_DRAIN = false; static constexpr int MIDT = 0;
    const float* ss; bf16_t* H; const PG8_LAS float* rl;
    __device__ __forceinline__ void operator()(const f32x4 (&acc)[2][2][4][2], const Unit& u, int wr, int wc, int fr, int fq) const {
        int row0 = u.pm * BM + wr * 64 + fr, col0 = u.pn * BM + 32 * wc + 8 * fq; asm volatile("" : "+v"(row0), "+v"(col0));
        float rsv[2][4]; rows_scale(rl, ss, row0, wr * 64 + fr, rsv);
#pragma unroll
        for (int ai = 0; ai < 2; ++ai)
#pragma unroll
            for (int m = 0; m < 4; ++m) {
                const int row = row0 + ai * HALF + m * 16; const float rs = rsv[ai][m];
#pragma unroll
                for (int bj = 0; bj < 2; ++bj) { f32x4 o[2];
#pragma unroll
                    for (int n = 0; n < 2; ++n) { const f32x4 x = acc[ai][bj][m][n] * rs;
#pragma unroll
                        for (int e = 0; e < 4; ++e) { const float r = fmaxf(x[e], 0.f); o[n][e] = r * r; } }
                    *(u32x4*)(H + (size_t)row * 4096 + col0 + 128 * bj) = pack8(o[0], o[1]); }
                asm volatile("" ::: "memory");
            }
    }
};
template <class Epi, class Sched, bool ALIGN_EPI = false, bool SP2 = false>
__device__ __forceinline__ void gemm_phase(PG8_LAS unsigned char* lds, const Gemm g, const Sched& S, const Epi& E) {
    int tid_o = threadIdx.x; asm volatile("" : "+v"(tid_o));
    const int tid = tid_o, wid = __builtin_amdgcn_readfirstlane(tid >> 6), lane = tid & 63, wr = wid >> 2, wc = wid & 3, fr = lane & 15, fq = lane >> 4;
    const int K = g.K, nt = K / BK;
    unsigned voffA[2], voffB[2];
#pragma unroll
    for (int i = 0; i < 2; ++i) { int R, C; stage_rc(tid * 16 + i * 8192, R, C); const int Rb = Epi::PERM ? ((R & ~31) + perm32(R & 31)) : R;
        voffA[i] = (unsigned)(R * g.lda + C) * 2u; voffB[i] = (unsigned)(Rb * g.ldb + C) * 2u; }
    const size_t kstep = (size_t)(BK * 2);
    const size_t hstepA = (size_t)HALF * g.lda * 2, hstepB = (size_t)HALF * g.ldb * 2;
    const size_t tstepA = 2 * hstepA, tstepB = 2 * hstepB;
    const unsigned ldsw = (unsigned)wid * 1024u;
    const int aoff = lds_byte(wr * 64 + fr, fq * 8), boff = lds_byte(wc * 32 + fr, fq * 8);
#define PG8_SA(b, h) (((b) * 2 + (h)) * HTB)
#define PG8_SB(b, h) ((4 + (b) * 2 + (h)) * HTB)
#define PG8_STAGE(bufoff, gbase, voff) do { _Pragma("unroll") for (int _i = 0; _i < 2; ++_i) \
        __builtin_amdgcn_global_load_lds((const unsigned*)((const char*)(gbase) + (voff)[_i]), (PG8_LAS unsigned*)(lds + (bufoff) + ldsw + _i * 8192), 16, 0, 0); } while (0)
#define PG8_LDA(dst, b, h) do { _Pragma("unroll") for (int m = 0; m < 4; ++m) _Pragma("unroll") for (int k = 0; k < 2; ++k) dst[m][k] = *(const PG8_LAS bf16x8*)(lds + PG8_SA(b, h) + aoff + m * 2048 + k * 1024); } while (0)
#define PG8_LDB(dst, b, h) do { _Pragma("unroll") for (int n = 0; n < 2; ++n) _Pragma("unroll") for (int k = 0; k < 2; ++k) dst[n][k] = *(const PG8_LAS bf16x8*)(lds + PG8_SB(b, h) + boff + n * 2048 + k * 1024); } while (0)
#define PG8_MMA(ai, bj, At, Bt) do { __builtin_amdgcn_s_setprio(1); _Pragma("unroll") for (int m = 0; m < 4; ++m) _Pragma("unroll") for (int n = 0; n < 2; ++n) _Pragma("unroll") for (int k = 0; k < 2; ++k) \
        acc[ai][bj][m][n] = __builtin_amdgcn_mfma_f32_16x16x32_bf16(Bt[n][k], At[m][k], acc[ai][bj][m][n], 0, 0, 0); __builtin_amdgcn_s_setprio(0); } while (0)
#define PG8_WAIT_V(n) asm volatile("s_waitcnt vmcnt(" #n ")" ::: "memory")
#define PG8_WAIT_L(n) asm volatile("s_waitcnt lgkmcnt(" #n ")" ::: "memory")
#define PG8_BAR __builtin_amdgcn_s_barrier()
#define PG8_SCHED __builtin_amdgcn_sched_barrier(0)
    Unit cur, nxt; int ui = 0;
    if (!S.next(0, cur)) return;
    f32x4 acc[2][2][4][2];
#pragma unroll
    for (int a = 0; a < 2; ++a)
#pragma unroll
        for (int b = 0; b < 2; ++b)
#pragma unroll
            for (int m = 0; m < 4; ++m)
#pragma unroll
                for (int n = 0; n < 2; ++n) acc[a][b][m][n] = (f32x4){0.f, 0.f, 0.f, 0.f};
    bf16x8 At[4][2], B0[2][2], B1[2][2];
    const char* cA = (const char*)g.A + (size_t)cur.pm * tstepA; const char* cB = (const char*)g.Bt + (size_t)cur.pn * tstepB;
    S.a_ready(cur);
    if constexpr (SP2) {
        PG8_STAGE(PG8_SB(0, 0), cB, voffB); PG8_STAGE(PG8_SB(0, 1), cB + hstepB, voffB); PG8_STAGE(PG8_SA(0, 0), cA, voffA); PG8_STAGE(PG8_SA(0, 1), cA + hstepA, voffA);
        if (wr == 1) PG8_BAR;
        PG8_WAIT_V(2); PG8_BAR;
        PG8_STAGE(PG8_SB(1, 0), cB + kstep, voffB); PG8_STAGE(PG8_SA(1, 0), cA + kstep, voffA); PG8_STAGE(PG8_SB(1, 1), cB + hstepB + kstep, voffB);
        PG8_WAIT_V(6); PG8_BAR;
    } else {
        PG8_STAGE(PG8_SB(0, 0), cB, voffB); PG8_STAGE(PG8_SA(0, 0), cA, voffA); PG8_STAGE(PG8_SB(0, 1), cB + hstepB, voffB); PG8_STAGE(PG8_SA(0, 1), cA + hstepA, voffA);
        if (wr == 1) PG8_BAR;
        PG8_WAIT_V(4); PG8_BAR;
        PG8_STAGE(PG8_SB(1, 0), cB + kstep, voffB); PG8_STAGE(PG8_SA(1, 0), cA + kstep, voffA); PG8_STAGE(PG8_SB(1, 1), cB + hstepB + kstep, voffB);
        PG8_WAIT_V(6); PG8_BAR;
    }
    for (;;) {
        const bool has_next = S.next(ui + 1, nxt);
        const char* nA = has_next ? (const char*)g.A + (size_t)nxt.pm * tstepA : cA; const char* nB = has_next ? (const char*)g.Bt + (size_t)nxt.pn * tstepB : cB;
        for (int t = 0; t < nt; t += 2) {
            if constexpr (Epi::MIDT > 0) { if (t == Epi::MIDT) E.mid(acc, cur, wr, wc, fr, fq); }
            const bool last = (t == nt - 2);
            const char* a1 = cA + (size_t)(t + 1) * kstep;
            const char* a2 = last ? nA : cA + (size_t)(t + 2) * kstep; const char* b2 = last ? nB : cB + (size_t)(t + 2) * kstep;
            const char* a3 = a2 + kstep; const char* b3 = b2 + kstep;
            if (last && has_next) S.a_ready(nxt);
            if constexpr (SP2) {
            PG8_LDB(B0, 0, 0); PG8_LDB(B1, 0, 1); PG8_SCHED; PG8_LDA(At, 0, 0); PG8_STAGE(PG8_SA(1, 1), a1 + hstepA, voffA);
            PG8_WAIT_V(8); PG8_WAIT_L(0); PG8_BAR; PG8_MMA(0, 0, At, B0); PG8_MMA(0, 1, At, B1); PG8_BAR; PG8_SCHED;
            PG8_LDA(At, 0, 1); PG8_STAGE(PG8_SB(0, 0), b2, voffB); PG8_STAGE(PG8_SB(0, 1), b2 + hstepB, voffB); PG8_STAGE(PG8_SA(0, 0), a2, voffA);
            PG8_WAIT_V(8); PG8_WAIT_L(0); PG8_BAR; PG8_MMA(1, 0, At, B0); PG8_MMA(1, 1, At, B1); PG8_BAR; PG8_SCHED;
            PG8_LDB(B0, 1, 0); PG8_LDB(B1, 1, 1); PG8_SCHED; PG8_LDA(At, 1, 0); PG8_STAGE(PG8_SA(0, 1), a2 + hstepA, voffA);
            PG8_WAIT_V(8); PG8_WAIT_L(0); PG8_BAR; PG8_MMA(0, 0, At, B0); PG8_MMA(0, 1, At, B1); PG8_BAR; PG8_SCHED;
            PG8_LDA(At, 1, 1); PG8_STAGE(PG8_SB(1, 0), b3, voffB); PG8_STAGE(PG8_SB(1, 1), b3 + hstepB, voffB); PG8_STAGE(PG8_SA(1, 0), a3, voffA);
            PG8_WAIT_V(8); PG8_WAIT_L(0); PG8_BAR; PG8_MMA(1, 0, At, B0); PG8_MMA(1, 1, At, B1); PG8_BAR; PG8_SCHED;
            } else {
            PG8_LDB(B0, 0, 0); PG8_SCHED; PG8_LDA(At, 0, 0); PG8_STAGE(PG8_SA(1, 1), a1 + hstepA, voffA);
            PG8_WAIT_L(8); PG8_BAR; PG8_WAIT_L(0); PG8_MMA(0, 0, At, B0); PG8_BAR; PG8_SCHED;
            PG8_LDB(B1, 0, 1); PG8_STAGE(PG8_SB(0, 0), b2, voffB);
            PG8_BAR; PG8_WAIT_L(0); PG8_MMA(0, 1, At, B1); PG8_BAR;
            PG8_LDA(At, 0, 1); PG8_STAGE(PG8_SA(0, 0), a2, voffA);
            PG8_BAR; PG8_WAIT_L(0); PG8_MMA(1, 0, At, B0); PG8_BAR; PG8_SCHED;
            PG8_STAGE(PG8_SB(0, 1), b2 + hstepB, voffB);
            PG8_WAIT_V(6); PG8_BAR; PG8_MMA(1, 1, At, B1); PG8_BAR;
            PG8_LDB(B0, 1, 0); PG8_SCHED; PG8_LDA(At, 1, 0); PG8_STAGE(PG8_SA(0, 1), a2 + hstepA, voffA);
            PG8_WAIT_L(8); PG8_BAR; PG8_WAIT_L(0); PG8_MMA(0, 0, At, B0); PG8_BAR; PG8_SCHED;
            PG8_LDB(B1, 1, 1); PG8_STAGE(PG8_SB(1, 0), b3, voffB);
            PG8_BAR; PG8_WAIT_L(0); PG8_MMA(0, 1, At, B1); PG8_BAR;
            PG8_LDA(At, 1, 1); PG8_STAGE(PG8_SA(1, 0), a3, voffA);
            PG8_BAR; PG8_WAIT_L(0); PG8_MMA(1, 0, At, B0); PG8_BAR; PG8_SCHED;
            PG8_STAGE(PG8_SB(1, 1), b3 + hstepB, voffB);
            PG8_WAIT_V(6); PG8_BAR; PG8_MMA(1, 1, At, B1); PG8_BAR;
            }
        }
        if constexpr (ALIGN_EPI) { if (wr == 0) PG8_BAR; }
        if constexpr (!Epi::AFTER_DRAIN) { E(acc, cur, wr, wc, fr, fq); S.done(cur); }
        if (!has_next) break;
#pragma unroll
        for (int a = 0; a < 2; ++a)
#pragma unroll
            for (int b = 0; b < 2; ++b)
#pragma unroll
                for (int m = 0; m < 4; ++m)
#pragma unroll
                    for (int n = 0; n < 2; ++n) acc[a][b][m][n] = (f32x4){0.f, 0.f, 0.f, 0.f};
        cur = nxt; cA = nA; cB = nB; ++ui;
        if constexpr (ALIGN_EPI) { if (wr == 1) PG8_BAR; }
    }
    PG8_WAIT_V(0);
    if constexpr (!ALIGN_EPI) { if (wr == 0) PG8_BAR; }
    PG8_BAR;
    if constexpr (Epi::AFTER_DRAIN) { E.fused(acc, cur, wr, wc, fr, fq, lds, wid, lane); S.done(cur); }
#undef PG8_SA
#undef PG8_SB
#undef PG8_STAGE
#undef PG8_LDA
#undef PG8_LDB
#undef PG8_MMA
#undef PG8_WAIT_V
#undef PG8_WAIT_L
#undef PG8_BAR
#undef PG8_SCHED
}
}
#include <hip/hip_bf16.h>
#include <cmath>
namespace attn_body {
using bf16=__hip_bfloat16;
using bf16x8=__attribute__((ext_vector_type(8)))short;
using s16x4=__attribute__((ext_vector_type(4)))short;
using f32x16=__attribute__((ext_vector_type(16)))float;
using u32x4=__attribute__((ext_vector_type(4)))unsigned;
constexpr int BATCH=2,SEQ=8192,D=64,QP=768,KVP=256,OP=1024;
constexpr int NW=8,QBLK=32,QB=QBLK*NW,KVBLK=64,NQB=SEQ/QB;
constexpr int ATTN_UNIT_ROWS=QB;
__device__ __forceinline__ int crow(int r,int hi){return (r&3)+8*(r>>2)+4*hi;}
#define SBAR() __builtin_amdgcn_sched_barrier(0)
__device__ __forceinline__ void cmask(f32x16&p0,f32x16&p1,int jb,int qrel,int hi){
  const float NEG=-INFINITY; int kb=64*jb+4*hi;
  #pragma unroll
  for(int r=0;r<16;++r){int kv=kb+(r&3)+8*(r>>2); if(kv>qrel)p0[r]=NEG; if(kv+32>qrel)p1[r]=NEG;}
}

constexpr int NSLOT=3, SLOTB=8192;
constexpr int LDS_K=0, LDS_V=NSLOT*SLOTB, LDS_WS=2*NSLOT*SLOTB, LDS_OST=LDS_WS+NW*64*4, LDS_BYTES=LDS_OST+NW*4096;
constexpr float C2=0.125f*1.4426950408889634f;
__device__ __forceinline__ void glds16(const void*gsrc,unsigned lds_dst){unsigned keep;
  asm volatile("s_mov_b32 %0, m0\n\ts_mov_b32 m0, %2\n\ts_nop 0\n\tglobal_load_lds_dwordx4 %1, off\n\ts_mov_b32 m0, %0":"=&s"(keep):"v"(gsrc),"s"(lds_dst):"memory");}
__device__ __forceinline__ float max3f(float a,float b,float c){float r;asm("v_max3_f32 %0, %1, %2, %3":"=v"(r):"v"(a),"v"(b),"v"(c));return r;}
__device__ __forceinline__ float max2f(float a,float b){float r;asm("v_max_f32_e32 %0, %1, %2":"=v"(r):"v"(a),"v"(b));return r;}
__device__ __forceinline__ float fadd_s(float a,float b){float r;asm("v_add_f32_e32 %0, %1, %2":"=v"(r):"v"(a),"v"(b));return r;}
__device__ __forceinline__ float fsub_s(float a,float b){float r;asm("v_sub_f32_e32 %0, %1, %2":"=v"(r):"v"(a),"v"(b));return r;}
typedef float f32x2_t __attribute__((ext_vector_type(2))); typedef __bf16 bf16x2_t __attribute__((ext_vector_type(2)));
__device__ __forceinline__ unsigned cvtpk_s(float lo,float hi){f32x2_t v={lo,hi};bf16x2_t b=__builtin_convertvector(v,bf16x2_t);return __builtin_bit_cast(unsigned,b);}
#define WAIT_BAR(N) asm volatile("s_waitcnt vmcnt(" #N ") lgkmcnt(0)\n\ts_barrier":::"memory")

__device__ __forceinline__ void qkt(f32x16&p0,f32x16&p1,const char*Kslot,const bf16x8*qr,const f32x16&negm,int r32,int hi){
  const char*kb=Kslot+hi*1024+r32*16;
  #pragma unroll
  for(int d0=0;d0<4;++d0){
    const bf16x8 b0=*reinterpret_cast<const bf16x8*>(kb+d0*2048);
    const bf16x8 b1=*reinterpret_cast<const bf16x8*>(kb+d0*2048+512);
    if(d0==0){p0=__builtin_amdgcn_mfma_f32_32x32x16_bf16(b0,qr[0],negm,0,0,0);p1=__builtin_amdgcn_mfma_f32_32x32x16_bf16(b1,qr[0],negm,0,0,0);}
    else{p0=__builtin_amdgcn_mfma_f32_32x32x16_bf16(b0,qr[d0],p0,0,0,0);p1=__builtin_amdgcn_mfma_f32_32x32x16_bf16(b1,qr[d0],p1,0,0,0);}}
}
typedef __attribute__((address_space(3))) const char* lds_cptr;
typedef short v4i16_t __attribute__((ext_vector_type(4)));
__device__ __forceinline__ void kload8(bf16x8*kf,lds_cptr kp){
  kf[0]=*(const __attribute__((address_space(3))) bf16x8*)(kp);      kf[1]=*(const __attribute__((address_space(3))) bf16x8*)(kp+512);
  kf[2]=*(const __attribute__((address_space(3))) bf16x8*)(kp+2048); kf[3]=*(const __attribute__((address_space(3))) bf16x8*)(kp+2560);
  kf[4]=*(const __attribute__((address_space(3))) bf16x8*)(kp+4096); kf[5]=*(const __attribute__((address_space(3))) bf16x8*)(kp+4608);
  kf[6]=*(const __attribute__((address_space(3))) bf16x8*)(kp+6144); kf[7]=*(const __attribute__((address_space(3))) bf16x8*)(kp+6656);
}
__device__ __forceinline__ void kload2(bf16x8*kf,lds_cptr kp,int j){ kf[2*j]=*(const __attribute__((address_space(3))) bf16x8*)(kp+j*2048); kf[2*j+1]=*(const __attribute__((address_space(3))) bf16x8*)(kp+j*2048+512); }
__device__ __forceinline__ s16x4 vtr(lds_cptr p){ return __builtin_bit_cast(s16x4,__builtin_amdgcn_ds_read_tr16_b64_v4i16((__attribute__((address_space(3))) v4i16_t*)p)); }
__device__ __forceinline__ float rowmax(const f32x16&p0,const f32x16&p1){
  float a=max3f(p0[0],p0[1],p1[0]),b=max3f(p0[2],p0[3],p1[1]);a=max3f(a,p1[2],p1[3]);
  #pragma unroll
  for(int r=4;r<16;r+=4){a=max3f(a,p0[r],p0[r+1]);b=max3f(b,p0[r+2],p0[r+3]);a=max3f(a,p1[r],p1[r+1]);b=max3f(b,p1[r+2],p1[r+3]);}
  const float m=max2f(a,b);
  auto rr=__builtin_amdgcn_permlane32_swap(__float_as_uint(m),__float_as_uint(m),false,false);
  return max2f(__uint_as_float(rr[0]),__uint_as_float(rr[1]));
}
__device__ __forceinline__ void pv(f32x16*o,int vb,bf16x8 pa0,bf16x8 pa1,bf16x8 pa2,bf16x8 pa3){
  #pragma unroll
  for(int d0=0;d0<2;++d0){s16x4 lo[4],hi[4];
    #pragma unroll
    for(int ks=0;ks<4;++ks){
      asm volatile("ds_read_b64_tr_b16 %0,%1 offset:%c2":"=&v"(lo[ks]):"v"(vb),"i"(d0*4096+ks*1024):"memory");
      asm volatile("ds_read_b64_tr_b16 %0,%1 offset:%c2":"=&v"(hi[ks]):"v"(vb),"i"(d0*4096+ks*1024+512):"memory");}
    asm volatile("s_waitcnt lgkmcnt(0)":::"memory");SBAR();
    #define PK(k) (bf16x8){lo[k][0],lo[k][1],lo[k][2],lo[k][3],hi[k][0],hi[k][1],hi[k][2],hi[k][3]}
    o[d0]=__builtin_amdgcn_mfma_f32_32x32x16_bf16(pa0,PK(0),o[d0],0,0,0);
    o[d0]=__builtin_amdgcn_mfma_f32_32x32x16_bf16(pa1,PK(1),o[d0],0,0,0);
    o[d0]=__builtin_amdgcn_mfma_f32_32x32x16_bf16(pa2,PK(2),o[d0],0,0,0);
    o[d0]=__builtin_amdgcn_mfma_f32_32x32x16_bf16(pa3,PK(3),o[d0],0,0,0);
    #undef PK
  }
}

#ifndef ATTN_STORE16
#define ATTN_STORE16(p,v) (*(u32x4*)(p)=(v))
#endif
template<int THRL> __device__ __forceinline__ void attn_unit(int b,int h,int kvh,int qb,const bf16*Q,const bf16*__restrict__ K,const bf16*__restrict__ V,bf16*O,char*shm){
  int tid_o=threadIdx.x; asm volatile("":"+v"(tid_o)); const int tid=tid_o,lane=tid&63,r32=lane&31,hi=lane>>5; const int wid=__builtin_amdgcn_readfirstlane(tid>>6);
  const long rowbase=(long)b*SEQ; const int q0=qb*QB;
  const bf16*Qw=Q+(rowbase+q0+wid*QBLK)*QP+h*D;
  const bf16*Kh=K+rowbase*KVP+kvh*D,*Vh=V+rowbase*KVP+kvh*D;
  const unsigned lds0=(unsigned)(uintptr_t)shm;
  float*wsf=(float*)(shm+LDS_WS)+wid*64;
  const bf16*ksrc=Kh+(long)lane*KVP+wid*8;
  const bf16*vsrc=Vh+(long)(16*(wid&3)+(lane>>2))*KVP+(wid>>2)*32+(lane&3)*8;
  const unsigned kdst=lds0+LDS_K+wid*1024, vdst=lds0+LDS_V+wid*1024;
  #define DMA_K(t,slot) glds16(ksrc+(long)(t)*KVBLK*KVP,(unsigned)__builtin_amdgcn_readfirstlane(kdst+(slot)))
  #define DMA_V(t,slot) glds16(vsrc+(long)(t)*KVBLK*KVP,(unsigned)__builtin_amdgcn_readfirstlane(vdst+(slot)))
  const int vb0=(int)(lds0+LDS_V)+((lane>>4)&1)*32+(lane&3)*8+(4*hi+((lane&15)>>2))*64;
  const char*Kbase=shm+LDS_K; bf16x8 kf[8];
  const lds_cptr shm3=(lds_cptr)shm; const lds_cptr kp0=shm3+LDS_K+hi*1024+r32*16; const lds_cptr vp0=shm3+LDS_V+((lane>>4)&1)*32+(lane&3)*8+(4*hi+((lane&15)>>2))*64;
  const int NT=SEQ/KVBLK;
  DMA_K(0,0);DMA_V(0,0);DMA_K(1,SLOTB);
  bf16x8 qr[4];
  #pragma unroll
  for(int d0=0;d0<4;++d0)qr[d0]=*reinterpret_cast<const bf16x8*>(&Qw[(long)r32*QP+d0*16+hi*8]);
  float mhat=0.f,l_reg=0.f;f32x16 o[2];o[0]=f32x16{};o[1]=f32x16{};f32x16 negm=f32x16{};asm volatile("":"+v"(negm));
  #define CMASK(P0,P1,t) do{}while(0)
  bool resc=false;
  #define START(P0,P1) do{ const float rm=rowmax(P0,P1); resc=false; \
    { const float dl=rm; mhat=fadd_s(mhat,dl); \
      _Pragma("unroll") for(int r=0;r<16;++r){P0[r]=fsub_s(P0[r],dl);P1[r]=fsub_s(P1[r],dl);} \
      _Pragma("unroll") for(int r=0;r<16;++r)negm[r]=-mhat; asm volatile("":"+v"(negm)); } \
    _Pragma("unroll") for(int r=0;r<16;++r)P0[r]=__builtin_amdgcn_exp2f(P0[r]); }while(0)
  #define RESC() do{ if(resc){ asm volatile("s_waitcnt lgkmcnt(0)":::"memory"); \
      _Pragma("unroll") for(int d_=0;d_<2;++d_) _Pragma("unroll") for(int r=0;r<16;++r)o[d_][r]*=wsf[crow(r,hi)]; } }while(0)
  f32x16 pA0,pA1,pB0,pB1;
  int sl_prev=0,sl_cur=0,sl_next=SLOTB;
  #define ROT() do{sl_prev=sl_cur;sl_cur=sl_next;sl_next=(sl_next==(NSLOT-1)*SLOTB)?0:sl_next+SLOTB;}while(0)
  DMA_K(2,2*SLOTB);
  WAIT_BAR(3);
  qkt(pA0,pA1,Kbase,qr,negm,r32,hi);asm volatile("s_nop 15\n\ts_nop 7":"+v"(pA0),"+v"(pA1));CMASK(pA0,pA1,0);
  START(pA0,pA1);
  _Pragma("unroll") for(int r=0;r<16;++r)pA1[r]=__builtin_amdgcn_exp2f(pA1[r]);
  WAIT_BAR(0);
  DMA_K(3,0);DMA_V(1,SLOTB);
  ROT();
  kload8(kf,kp0+sl_cur);
  WAIT_BAR(2);
  s16x4 vlo[8],vhi[8]; u32x4 pw0,pw1,pw2,pw3;
  #define PKW(P,B) cvtpk_s(P[B],P[B+1])
  #define PAF(k) __builtin_bit_cast(bf16x8,pw##k)
  #define VFR(i) (bf16x8){vlo[i][0],vlo[i][1],vlo[i][2],vlo[i][3],vhi[i][0],vhi[i][1],vhi[i][2],vhi[i][3]}
  #define PIN(x) asm volatile("":"+v"(x))
  #define MX3(a,b,c) __builtin_fmaxf(__builtin_fmaxf((a),(b)),(c))
  #define GAPA(MF,A0,A1,A2,A3,W0,W1,PW) do{ MF; sacc+=A0; sacc+=A1; sacc+=A2; sacc+=A3; PIN(sacc); W0; W1; PIN(PW); SBAR(); }while(0)
  #define EX(v) __builtin_amdgcn_exp2f(v)
  #define GAPB(MF,X,B) do{ MF; X[B]=EX(X[B]); X[B+1]=EX(X[B+1]); X[B+2]=EX(X[B+2]); X[B+3]=EX(X[B+3]); PIN(X); SBAR(); }while(0)
  #define VRD(i) do{ vlo[i]=vtr(vp_+(((i)>>2)*4096+((i)&3)*1024)); vhi[i]=vtr(vp_+(((i)>>2)*4096+((i)&3)*1024+512)); }while(0)
  #define KRD(G,j) do{ if(G){ kload2(kf,kp0+sl_next,j); SBAR(); } }while(0)
  #define STEP(C0,C1,P0,P1,t,GK,GV,GL) do{ SBAR(); \
    const lds_cptr vp_=vp0+sl_prev; \
    VRD(0); SBAR(); float sacc=(P0[0]+P0[1]); \
    GAPA(C0=__builtin_amdgcn_mfma_f32_32x32x16_bf16(kf[0],qr[0],negm,0,0,0), P0[2],P0[3],P0[4],P0[5],     pw0[0]=PKW(P0,0), pw0[1]=PKW(P0,2), pw0); \
    VRD(4); SBAR(); GAPA(C1=__builtin_amdgcn_mfma_f32_32x32x16_bf16(kf[1],qr[0],negm,0,0,0), P0[6],P0[7],P0[8],P0[9],     pw0[2]=PKW(P0,4), pw0[3]=PKW(P0,6), pw0); \
    VRD(1); SBAR(); GAPA(C0=__builtin_amdgcn_mfma_f32_32x32x16_bf16(kf[2],qr[1],C0,0,0,0),   P0[10],P0[11],P0[12],P0[13], pw1[0]=PKW(P0,8), pw1[1]=PKW(P0,10), pw1); \
    VRD(5); SBAR(); GAPA(C1=__builtin_amdgcn_mfma_f32_32x32x16_bf16(kf[3],qr[1],C1,0,0,0),   P0[14],P0[15],P1[0],P1[1],   pw1[2]=PKW(P0,12),pw1[3]=PKW(P0,14), pw1); \
    VRD(2); SBAR(); GAPA(C0=__builtin_amdgcn_mfma_f32_32x32x16_bf16(kf[4],qr[2],C0,0,0,0),   P1[2],P1[3],P1[4],P1[5],     pw2[0]=PKW(P1,0), pw2[1]=PKW(P1,2), pw2); \
    VRD(6); SBAR(); GAPA(C1=__builtin_amdgcn_mfma_f32_32x32x16_bf16(kf[5],qr[2],C1,0,0,0),   P1[6],P1[7],P1[8],P1[9],     pw2[2]=PKW(P1,4), pw2[3]=PKW(P1,6), pw2); \
    VRD(3); SBAR(); GAPA(C0=__builtin_amdgcn_mfma_f32_32x32x16_bf16(kf[6],qr[3],C0,0,0,0),   P1[10],P1[11],P1[12],P1[13], pw3[0]=PKW(P1,8), pw3[1]=PKW(P1,10), pw3); \
    VRD(7); SBAR(); GAPA(C1=__builtin_amdgcn_mfma_f32_32x32x16_bf16(kf[7],qr[3],C1,0,0,0),   P1[14],P1[15],0.f,0.f,       pw3[2]=PKW(P1,12),pw3[3]=PKW(P1,14), pw3); \
    l_reg+=sacc; \
    if(GK){DMA_K((t)+3,sl_cur);} if(GV){DMA_V((t)+1,sl_next);} \
    CMASK(C0,C1,t); \
    { float a=MX3(C0[0],C0[1],C1[0]),b=MX3(C0[2],C0[3],C1[1]); a=MX3(a,C1[2],C1[3]); \
      _Pragma("unroll") for(int r=4;r<16;r+=4){a=MX3(a,C0[r],C0[r+1]);b=MX3(b,C0[r+2],C0[r+3]);a=MX3(a,C1[r],C1[r+1]);b=MX3(b,C1[r+2],C1[r+3]);} \
      float rm=__builtin_fmaxf(a,b); { auto rr=__builtin_amdgcn_permlane32_swap(__float_as_uint(rm),__float_as_uint(rm),false,false); rm=__builtin_fmaxf(__uint_as_float(rr[0]),__uint_as_float(rr[1])); } \
      resc=false; \
      if(__builtin_expect(__any(rm>(float)THRL),0)){ const float dl=__builtin_fmaxf(rm,0.f); mhat+=dl; \
        _Pragma("unroll") for(int r=0;r<16;++r){C0[r]-=dl;C1[r]-=dl;} \
        _Pragma("unroll") for(int r=0;r<16;++r)negm[r]=-mhat; asm volatile("":"+v"(negm)); \
        const float f=__builtin_amdgcn_exp2f(-dl); l_reg*=f; if(hi==0)wsf[r32]=f; resc=true; } } \
    SBAR(); \
    GAPB(o[0]=__builtin_amdgcn_mfma_f32_32x32x16_bf16(PAF(0),VFR(0),o[0],0,0,0), C0,0); \
    GAPB(o[1]=__builtin_amdgcn_mfma_f32_32x32x16_bf16(PAF(0),VFR(4),o[1],0,0,0), C0,4); \
    KRD(GL,0); GAPB(o[0]=__builtin_amdgcn_mfma_f32_32x32x16_bf16(PAF(1),VFR(1),o[0],0,0,0), C0,8); \
    KRD(GL,1); GAPB(o[1]=__builtin_amdgcn_mfma_f32_32x32x16_bf16(PAF(1),VFR(5),o[1],0,0,0), C0,12); \
    KRD(GL,2); GAPB(o[0]=__builtin_amdgcn_mfma_f32_32x32x16_bf16(PAF(2),VFR(2),o[0],0,0,0), C1,0); \
    KRD(GL,3); GAPB(o[1]=__builtin_amdgcn_mfma_f32_32x32x16_bf16(PAF(2),VFR(6),o[1],0,0,0), C1,4); \
    GAPB(o[0]=__builtin_amdgcn_mfma_f32_32x32x16_bf16(PAF(3),VFR(3),o[0],0,0,0), C1,8); \
    GAPB(o[1]=__builtin_amdgcn_mfma_f32_32x32x16_bf16(PAF(3),VFR(7),o[1],0,0,0), C1,12); \
    }while(0)
  int t=1;
  #undef CMASK
  #define CMASK(P0,P1,t) do{}while(0)
  for(;t+5<NT;t+=2){
    STEP(pB0,pB1,pA0,pA1,t,true,true,true);     WAIT_BAR(2); RESC(); ROT();
    STEP(pA0,pA1,pB0,pB1,t+1,true,true,true);   WAIT_BAR(2); RESC(); ROT();
  }
  #undef CMASK
  #define CMASK(P0,P1,t) do{}while(0)
  #define ENDW(tt) do{ if((tt)+3<NT){WAIT_BAR(2);} else if((tt)+2<NT){WAIT_BAR(1);} else {WAIT_BAR(0);} }while(0)
  for(;t+1<NT;t+=2){
    STEP(pB0,pB1,pA0,pA1,t,(t+3<NT),(t+1<NT),(t+1<NT));       ENDW(t);   RESC(); ROT();
    STEP(pA0,pA1,pB0,pB1,t+1,(t+4<NT),(t+2<NT),(t+2<NT));     ENDW(t+1); RESC(); ROT();
  }
  STEP(pB0,pB1,pA0,pA1,NT-1,false,false,false); RESC();
  { float sacc=pB0[0]+pB0[1]; _Pragma("unroll") for(int r=2;r<16;++r)sacc+=pB0[r]; _Pragma("unroll") for(int r=0;r<16;++r)sacc+=pB1[r]; l_reg+=sacc;
    pw0=(u32x4){PKW(pB0,0),PKW(pB0,2),PKW(pB0,4),PKW(pB0,6)};pw1=(u32x4){PKW(pB0,8),PKW(pB0,10),PKW(pB0,12),PKW(pB0,14)};pw2=(u32x4){PKW(pB1,0),PKW(pB1,2),PKW(pB1,4),PKW(pB1,6)};pw3=(u32x4){PKW(pB1,8),PKW(pB1,10),PKW(pB1,12),PKW(pB1,14)};
    SBAR(); pv(o,vb0+sl_cur,PAF(0),PAF(1),PAF(2),PAF(3)); }
  #undef PKW
  #undef PAF
  #undef VFR
  #undef PIN
  #undef MX3
  #undef GAPA
  #undef GAPB
  #undef EX
  #undef VRD
  #undef KRD
  #undef STEP
  #undef ENDW
  {auto rr=__builtin_amdgcn_permlane32_swap(__float_as_uint(l_reg),__float_as_uint(l_reg),false,false);l_reg=__uint_as_float(rr[0])+__uint_as_float(rr[1]);}
  if(hi==0)wsf[32+r32]=l_reg;asm volatile("s_waitcnt lgkmcnt(0)":::"memory");
  float rli[16];
  #pragma unroll
  for(int r=0;r<16;++r)rli[r]=__builtin_amdgcn_rcpf(wsf[32+crow(r,hi)]);
  bf16*Ow=O+(rowbase+q0+wid*QBLK)*OP+h*D;
  { bf16*stg=(bf16*)(shm+LDS_OST)+wid*2048;
    #pragma unroll
    for(int r=0;r<16;++r){const int orow=crow(r,hi);
      #pragma unroll
      for(int d0=0;d0<2;++d0)stg[orow*64+d0*32+r32]=__float2bfloat16(o[d0][r]*rli[r]);}
    asm volatile("s_waitcnt lgkmcnt(0)":::"memory");
    #pragma unroll
    for(int i=0;i<4;++i){const int row=i*8+(lane>>3),ch=lane&7; const u32x4 v=*(const u32x4*)(stg+row*64+ch*8); ATTN_STORE16(Ow+(long)row*OP+ch*8,v);} }
  asm volatile("s_waitcnt lgkmcnt(0)\n\ts_barrier":::"memory");
  #undef DMA_K
  #undef DMA_V
  #undef CMASK
  #undef START
  #undef RESC
  #undef ROT
}
constexpr int ATTN_LDS_BYTES=LDS_BYTES;
struct AttnTensors { const bf16* Q; const bf16* K; const bf16* V; bf16* O; };
template<int THRL=8> __device__ __forceinline__ void attn_phase(char*lds,const AttnTensors&T,int vcu,int G){
  for(int u=vcu;u<768;u+=G){ const int j=u&31,grp=(u>>5)&7,i=u>>8; const int b=grp>>2,kvh=grp&3,h=kvh*3+i;
    attn_unit<THRL>(b,h,kvh,j,T.Q,T.K,T.V,T.O,lds); }
}
#undef SBAR
#undef WAIT_BAR
}
constexpr int NWAVES = 8;
#ifndef MK_PER_PHASE
#define MK_PER_PHASE 0
#endif
constexpr int BATCH = 2, T = 8192, D = 1024, FF = 4096, DEPTH = 4, INW = 3584;
constexpr int M = BATCH * T;
constexpr int N_PHASES = 2 + 7 * DEPTH;
constexpr size_t MiB = 1u << 20;
constexpr size_t WS_SS = 1 * MiB;
constexpr size_t WS_W = 2 * MiB, W_LAYER_ELEMS = (size_t)27 * MiB / 2;
constexpr size_t WO_IN = 0, WO_AB = (size_t)INW * D, WO_OUT = WO_AB + (size_t)D * D, WO_UP = WO_OUT + (size_t)D * D, WO_DOWN = WO_UP + (size_t)FF * D;
static_assert(WO_DOWN + (size_t)D * FF == W_LAYER_ELEMS, "weight buffer");
constexpr size_t WS_XB = 56 * MiB;
constexpr size_t WS_Q = 88 * MiB, WS_K = 112 * MiB, WS_V = 120 * MiB, WS_F = 128 * MiB, WS_G = 136 * MiB, WS_AO = 200 * MiB, WS_YP = 232 * MiB, WS_END = 248 * MiB;
constexpr size_t WS_MG = WS_Q;
constexpr size_t WS_H = WS_Q;
static_assert(WS_H + (size_t)M * FF * 2 <= WS_YP, "h overlay");
constexpr int RING_BYTES = 131072, LDS_BYTES = 147456;
#define GAS __attribute__((address_space(1)))
#define LAS __attribute__((address_space(3)))
typedef unsigned short bf16;
typedef unsigned v4u __attribute__((ext_vector_type(4)));
typedef unsigned v2u __attribute__((ext_vector_type(2)));
typedef float f32x4 __attribute__((ext_vector_type(4)));
typedef short bf16x8 __attribute__((ext_vector_type(8)));
#define LDS_WAIT() asm volatile("s_waitcnt lgkmcnt(0)" ::: "memory")
__device__ __forceinline__ unsigned f2bf(float f) { unsigned u = __builtin_bit_cast(unsigned, f); return (u + 0x7fffu + ((u >> 16) & 1u)) >> 16; }
__device__ __forceinline__ unsigned pk2(float lo, float hi) { return f2bf(lo) | (f2bf(hi) << 16); }
__device__ __forceinline__ float wave_sum(float v) {
#pragma unroll
    for (int o = 1; o < 64; o <<= 1) v += __shfl_xor(v, o);
    return v;
}
__device__ __forceinline__ void transpose_item(const float* W, int ldw, const float* gain, bf16* WT, int ldt, int k0, int n0, int v0, int kcol0, LAS float* scr, int lane) {
    float wv[32];
#pragma unroll
    for (int i = 0; i < 32; ++i) wv[i] = W[(size_t)(k0 + 2 * i + (lane >> 5)) * ldw + n0 + (lane & 31)];
    if (gain) {
#pragma unroll
        for (int i = 0; i < 32; ++i) wv[i] *= gain[k0 + 2 * i + (lane >> 5)];
    }
#pragma unroll
    for (int i = 0; i < 32; ++i) scr[(2 * i + (lane >> 5)) * 33 + (lane & 31)] = wv[i];
    LDS_WAIT(); asm volatile("" ::: "memory");
    const int c = lane & 7;
#pragma unroll
    for (int j = 0; j < 4; ++j) { const int n = (lane >> 3) + 8 * j; const LAS float* s = scr + (8 * c) * 33 + n;
        v4u o; o.x = pk2(s[0 * 33], s[1 * 33]); o.y = pk2(s[2 * 33], s[3 * 33]); o.z = pk2(s[4 * 33], s[5 * 33]); o.w = pk2(s[6 * 33], s[7 * 33]);
        *(GAS v4u*)(WT + (size_t)(v0 + n) * ldt + kcol0 + k0 + 8 * c) = o; }
    LDS_WAIT(); asm volatile("" ::: "memory");
}
#define RLX_AGENT __ATOMIC_RELAXED, __HIP_MEMORY_SCOPE_AGENT

#define XB_TMO      128
#define XB_XCNT(j)  (256  + 64 * (j))
#define XB_XSUB(j)  (1280 + 64 * (j))
#define XB_XGEN(j)  (2304 + 64 * (j))
#define XB_TOP      3328
#define XB_TOPGEN   3392
#define XCD_BAR_WORDS 3456
#define XB_SPIN_CAP (1u << 18)

__device__ __forceinline__ unsigned xb_ld(unsigned* p)              { return __hip_atomic_load(p, __ATOMIC_RELAXED, __HIP_MEMORY_SCOPE_AGENT); }
__device__ __forceinline__ unsigned xb_add(unsigned* p, unsigned v) { return __hip_atomic_fetch_add(p, v, __ATOMIC_RELAXED, __HIP_MEMORY_SCOPE_AGENT); }
__device__ __forceinline__ unsigned xb_xcc_id() { return (unsigned)__builtin_amdgcn_s_getreg((3 << 11) | 20) & 0xFu; }
#define XB_SPIN(cond, bar) do { unsigned _sp = 0; while (cond) { __builtin_amdgcn_s_sleep(1); \
    if ((++_sp & 255u) == 0u) { if (xb_ld(&(bar)[XB_TMO])) break; if (_sp > XB_SPIN_CAP) { atomicAdd(&(bar)[XB_TMO], 1u); break; } } } } while (0)

struct XcdBarrier {
    unsigned* bar; unsigned x;
    volatile LAS unsigned* st;
};

__device__ __forceinline__ XcdBarrier xcd_barrier_post(unsigned* bar, volatile LAS unsigned* st) {
    XcdBarrier b; b.bar = bar; b.x = xb_xcc_id(); b.st = st;
    if (threadIdx.x == 0) (void)xb_add(&bar[XB_XCNT(b.x)], 1u);
    return b;
}
__device__ __forceinline__ void xcd_barrier_complete(unsigned* bar, unsigned x, unsigned& nloc, unsigned& nx) {
    const unsigned G = gridDim.x * gridDim.y * gridDim.z;
    unsigned sum, cnt, mine, sp = 0u;
    for (;;) {
        sum = 0u; cnt = 0u; mine = 0u;
#pragma unroll
        for (unsigned j = 0; j < 16; ++j) { const unsigned c = xb_ld(&bar[XB_XCNT(j)]); sum += c; cnt += (c > 0u) ? 1u : 0u; mine = (j == x) ? c : mine; }
        if (sum == G) break;
        __builtin_amdgcn_s_sleep(1);
        if ((++sp & 255u) == 0u) { if (xb_ld(&bar[XB_TMO])) break; if (sp > XB_SPIN_CAP) { atomicAdd(&bar[XB_TMO], 1u); break; } }
    }
    nloc = mine > 0u ? mine : 1u; nx = cnt > 0u ? cnt : 1u;
}

#define XB_BAD 192
__device__ __forceinline__ void xcd_barrier(const XcdBarrier& b, bool order_only = false) {
    asm volatile("s_waitcnt vmcnt(0)" ::: "memory");
    __syncthreads();
    if (threadIdx.x == 0) {
        unsigned* bar = b.bar;
        __builtin_amdgcn_s_waitcnt(0);
        unsigned nloc = b.st[0], nx = b.st[1];
        if (nloc == 0u) { xcd_barrier_complete(bar, b.x, nloc, nx); b.st[0] = nloc; b.st[1] = nx; }
        const unsigned old = xb_add(&bar[XB_XSUB(b.x)], 1u);
        const unsigned gen = old / nloc;
        if (old + 1u == (gen + 1u) * nloc) {
            if (!(order_only && xb_ld(&bar[XB_BAD]) == 0u)) __builtin_amdgcn_fence(__ATOMIC_RELEASE, "agent");
            asm volatile("s_waitcnt vmcnt(0)" ::: "memory");
            const unsigned og = xb_add(&bar[XB_TOP], 1u);
            const unsigned tg = og / nx;
            if (og + 1u == (tg + 1u) * nx) xb_add(&bar[XB_TOPGEN], 1u);
            else XB_SPIN(xb_ld(&bar[XB_TOPGEN]) == tg, bar);
            __builtin_amdgcn_fence(__ATOMIC_ACQUIRE, "agent");
            xb_add(&bar[XB_XGEN(b.x)], 1u);
            asm volatile("s_waitcnt vmcnt(0)" ::: "memory");
        } else {
            XB_SPIN(xb_ld(&bar[XB_XGEN(b.x)]) == gen, bar);
            __builtin_amdgcn_fence(__ATOMIC_ACQUIRE, "agent");
            asm volatile("s_waitcnt vmcnt(0)" ::: "memory");
        }
    }
    __syncthreads();
}
constexpr int RSTD_OFF = RING_BYTES + 1024;
constexpr int MISC_OFF = RING_BYTES + 320;
constexpr size_t WS_GCNT = 131072;
constexpr size_t WS_CNT = 65536;
constexpr size_t WS_BAR = 16384;
constexpr size_t WS_XTAB = 163840;
__device__ __forceinline__ void group_barrier(unsigned* cnt, const unsigned* xtab, volatile LAS unsigned* same_xcc, unsigned* bad) {
    asm volatile("s_waitcnt vmcnt(0)" ::: "memory");
    __syncthreads();
    if (threadIdx.x == 0) {
        unsigned sx = *same_xcc;
        if (sx == 0u) { const unsigned g = blockIdx.x & 63u; const unsigned a = xb_ld((unsigned*)xtab + g), b = xb_ld((unsigned*)xtab + g + 64), c = xb_ld((unsigned*)xtab + g + 128), d = xb_ld((unsigned*)xtab + g + 192);
            sx = (a != 0u && a == b && b == c && c == d) ? 1u : 2u; *same_xcc = sx;
            if (sx == 2u) { __hip_atomic_store(bad, 1u, __ATOMIC_RELAXED, __HIP_MEMORY_SCOPE_AGENT); asm volatile("s_waitcnt vmcnt(0)" ::: "memory"); } }
        if (sx != 1u) { __builtin_amdgcn_fence(__ATOMIC_RELEASE, "agent"); asm volatile("s_waitcnt vmcnt(0)" ::: "memory"); }
        const unsigned old = xb_add(cnt, 1u), target = (old / 4u + 1u) * 4u; unsigned sp = 0;
        while (xb_ld(cnt) < target) { __builtin_amdgcn_s_sleep(1); if (++sp > (1u << 24)) break; }
        __builtin_amdgcn_fence(__ATOMIC_ACQUIRE, "agent"); asm volatile("s_waitcnt vmcnt(0)" ::: "memory");
    }
    __syncthreads();
}
struct Args { const float* in[13]; float* out; unsigned char* ws; int ph_lo, ph_hi; };
__device__ __forceinline__ void convert_layer(const __attribute__((address_space(4))) Args* a, int L, bf16* wbuf, LAS float* scr, int gw, int NGW, int lane, int part) {
    asm volatile("" : "+v"(lane));
    constexpr int I_IN = 16 * 112, I_A = 12 * 32, I_F = 4 * 32, I_O = 16 * 32, I_UP = 16 * 128, I_DN = 64 * 32, NITEMS = I_IN + I_A + I_F + I_O + I_UP + I_DN;
    const int it_lo = (part == 2) ? I_IN : 0, it_hi = (part == 1) ? I_IN : NITEMS;
    for (int it = it_lo + gw; it < it_hi; it += NGW) {
        int r = it;
        if (r < I_IN) { const int kb = r / 112, n0 = 32 * (r % 112); const int v0 = (n0 < 1024) ? (n0 & ~255) + 128 * ((n0 >> 5) & 1) + 32 * ((n0 >> 6) & 3) : n0;
            transpose_item(a->in[2] + (size_t)L * D * INW, INW, a->in[1] + L * D, wbuf + WO_IN, D, 64 * kb, n0, v0, 0, scr, lane); continue; } r -= I_IN;
        if (r < I_A) { transpose_item(a->in[6] + (size_t)L * 768 * D, D, nullptr, wbuf + WO_AB, D, 64 * (r / 32), 32 * (r % 32), 32 * (r % 32), 0, scr, lane); continue; } r -= I_A;
        if (r < I_F) { transpose_item(a->in[7] + (size_t)L * 256 * D, D, nullptr, wbuf + WO_AB, D, 64 * (r / 32), 32 * (r % 32), 32 * (r % 32), 768, scr, lane); continue; } r -= I_F;
        if (r < I_O) { transpose_item(a->in[8] + (size_t)L * D * D, D, nullptr, wbuf + WO_OUT, D, 64 * (r / 32), 32 * (r % 32), 32 * (r % 32), 0, scr, lane); continue; } r -= I_O;
        if (r < I_UP) { transpose_item(a->in[10] + (size_t)L * D * FF, FF, a->in[9] + L * D, wbuf + WO_UP, D, 64 * (r / 128), 32 * (r % 128), 32 * (r % 128), 0, scr, lane); continue; } r -= I_UP;
        transpose_item(a->in[11] + (size_t)L * FF * D, D, nullptr, wbuf + WO_DOWN, FF, 64 * (r / 32), 32 * (r % 32), 32 * (r % 32), 0, scr, lane);
    }
}
__device__ __forceinline__ unsigned short f2bf16(float f) { return (unsigned short)f2bf(f); }
#define MFMA16(a, b, c) __builtin_amdgcn_mfma_f32_16x16x32_bf16((a), (b), (c), 0, 0, 0)
__device__ __forceinline__ void fourier_a_phase(LAS unsigned char* lds, const bf16* Fb, bf16* Yp, int vcu, int G, int tid) {
    asm volatile("" : "+v"(tid));
    const int lane = tid & 63, w = __builtin_amdgcn_readfirstlane(tid >> 6), fr = lane & 15, fq = lane >> 4;
    constexpr int XS = 144, TS = 272, T_OFF = 128 * XS;
    bf16x8 w1[2], cb[4], sb[4];
    { const int n = 16 * w + fr, cp = n & 63; const bool isS = n >= 64;
#pragma unroll
      for (int ks = 0; ks < 2; ++ks)
#pragma unroll
        for (int e = 0; e < 8; ++e) { const int c = 32 * ks + 8 * fq + e; const float ph = (float)((cp * c) & 63) * (1.0f / 64.0f);
            w1[ks][e] = (short)f2bf16((isS ? __builtin_amdgcn_sinf(ph) : __builtin_amdgcn_cosf(ph)) * 0.125f); } }
    const int k1 = 16 * w + fr;
#pragma unroll
    for (int ks = 0; ks < 4; ++ks)
#pragma unroll
        for (int e = 0; e < 8; ++e) { const int r = 32 * ks + 8 * fq + e; const float ph = (float)((k1 * r) & 127) * (1.0f / 128.0f);
            cb[ks][e] = (short)f2bf16(__builtin_amdgcn_cosf(ph) * 0.08838834764831845f); sb[ks][e] = (short)f2bf16(__builtin_amdgcn_sinf(ph) * 0.08838834764831845f); }
    v4u xd[2];
#define FA_LOAD(IT) do { const int cc_ = (IT) & 63, g_ = ((IT) >> 6) & 3, b_ = (IT) >> 8; _Pragma("unroll") for (int i = 0; i < 2; ++i) { const int chunk = tid + 512 * i, r = chunk >> 3, ch = chunk & 7; \
        xd[i] = *(const GAS v4u*)(Fb + ((size_t)(b_ * 8192 + 64 * r + cc_) * 256 + g_ * 64 + ch * 8)); } } while (0)
#define FA_PUT() do { _Pragma("unroll") for (int i = 0; i < 2; ++i) { const int chunk = tid + 512 * i, r = chunk >> 3, ch = chunk & 7; *(LAS v4u*)(lds + r * XS + ch * 16) = xd[i]; } } while (0)
    if (vcu < 512) { FA_LOAD(vcu); FA_PUT(); }
    for (int it = vcu; it < 512; it += G) {
        const int cc = it & 63, g = (it >> 6) & 3, b = it >> 8;
        __syncthreads();
        f32x4 acc[8];
#pragma unroll
        for (int mt = 0; mt < 8; ++mt) { acc[mt] = (f32x4){0.f, 0.f, 0.f, 0.f};
#pragma unroll
            for (int ks = 0; ks < 2; ++ks) { const bf16x8 a = *(const LAS bf16x8*)(lds + (16 * mt + fr) * XS + (32 * ks + 8 * fq) * 2); acc[mt] = MFMA16(a, w1[ks], acc[mt]); } }
#pragma unroll
        for (int mt = 0; mt < 8; ++mt) { v2u o; o.x = pk2(acc[mt][0], acc[mt][1]); o.y = pk2(acc[mt][2], acc[mt][3]);
            *(LAS v2u*)(lds + T_OFF + (16 * w + fr) * TS + (16 * mt + 4 * fq) * 2) = o; }
        __syncthreads();
        if (it + G < 512) FA_LOAD(it + G);
        const float tph = (float)((k1 * cc) & 8191) * (1.0f / 8192.0f); const float tc = __builtin_amdgcn_cosf(tph), ts = __builtin_amdgcn_sinf(tph);
        bf16* yo = Yp + (((size_t)((b * 4 + g) * 128 + k1) * 2) * 64 + cc) * 64 + 4 * fq;
#pragma unroll
        for (int ct = 0; ct < 4; ++ct) { f32x4 p1 = (f32x4){0.f, 0.f, 0.f, 0.f}, p2 = p1, p34 = p1;
#pragma unroll
            for (int ks = 0; ks < 4; ++ks) {
                const bf16x8 aTc = *(const LAS bf16x8*)(lds + T_OFF + (16 * ct + fr) * TS + (32 * ks + 8 * fq) * 2);
                const bf16x8 aTs = *(const LAS bf16x8*)(lds + T_OFF + (64 + 16 * ct + fr) * TS + (32 * ks + 8 * fq) * 2);
                p1 = MFMA16(aTc, cb[ks], p1); p2 = MFMA16(aTs, sb[ks], p2); p34 = MFMA16(aTc, sb[ks], p34); p34 = MFMA16(aTs, cb[ks], p34); }
            const f32x4 yre = p1 - p2, yim = -p34; const f32x4 ore = yre * tc + yim * ts, oim = yim * tc - yre * ts;
            v2u o; o.x = pk2(ore[0], ore[1]); o.y = pk2(ore[2], ore[3]); *(GAS v2u*)(yo + 16 * ct) = o;
            o.x = pk2(oim[0], oim[1]); o.y = pk2(oim[2], oim[3]); *(GAS v2u*)(yo + 64 * 64 + 16 * ct) = o; }
        if (it + G < 512) FA_PUT();
    }
    __syncthreads();
#undef FA_LOAD
#undef FA_PUT
}
__device__ __forceinline__ void fourier_b_phase(LAS unsigned char* lds, const bf16* Yp, bf16* AO, int vcu, int G, int tid) {
    asm volatile("" : "+v"(tid));
    const int lane = tid & 63, w = __builtin_amdgcn_readfirstlane(tid >> 6), fr = lane & 15, fq = lane >> 4, kt = w >> 1;
    constexpr int YS = 272;
    bf16x8 w2[4];
    const int k2 = 16 * kt + fr;
#pragma unroll
    for (int ks = 0; ks < 4; ++ks)
#pragma unroll
        for (int e = 0; e < 8; ++e) { const int K = 32 * ks + 8 * fq + e; const float ph = (float)((k2 * (K & 63)) & 63) * (1.0f / 64.0f);
            w2[ks][e] = (short)f2bf16((K >= 64 ? __builtin_amdgcn_sinf(ph) : __builtin_amdgcn_cosf(ph)) * 0.125f); }
    v4u yd[2];
#define FB_LOAD(IT) do { const bf16* src_ = Yp + (size_t)(((IT) >> 9) * 4 * 128 + (((IT) >> 7) & 3) * 128 + ((IT) & 127)) * 8192; _Pragma("unroll") for (int i = 0; i < 2; ++i) yd[i] = *(const GAS v4u*)(src_ + (size_t)(tid + 512 * i) * 8); } while (0)
    if (vcu < 1024) FB_LOAD(vcu);
    for (int it = vcu; it < 1024; it += G) {
        const int kk1 = it & 127, g = (it >> 7) & 3, b = it >> 9;
#pragma unroll
        for (int i = 0; i < 2; ++i) { const int chunk = tid + 512 * i, K = chunk >> 3, c0 = (chunk & 7) * 8;
            const v4u d = yd[i];
            LAS unsigned short* p = (LAS unsigned short*)(lds + c0 * YS + K * 2);
            p[0 * (YS / 2)] = (unsigned short)(d.x & 0xffffu); p[1 * (YS / 2)] = (unsigned short)(d.x >> 16); p[2 * (YS / 2)] = (unsigned short)(d.y & 0xffffu); p[3 * (YS / 2)] = (unsigned short)(d.y >> 16);
            p[4 * (YS / 2)] = (unsigned short)(d.z & 0xffffu); p[5 * (YS / 2)] = (unsigned short)(d.z >> 16); p[6 * (YS / 2)] = (unsigned short)(d.w & 0xffffu); p[7 * (YS / 2)] = (unsigned short)(d.w >> 16); }
        __syncthreads();
        if (it + G < 1024) FB_LOAD(it + G);
#pragma unroll
        for (int q = 0; q < 2; ++q) { const int ct = 2 * (w & 1) + q; f32x4 acc = (f32x4){0.f, 0.f, 0.f, 0.f};
#pragma unroll
            for (int ks = 0; ks < 4; ++ks) { const bf16x8 a = *(const LAS bf16x8*)(lds + (16 * ct + fr) * YS + (32 * ks + 8 * fq) * 2); acc = MFMA16(a, w2[ks], acc); }
            v2u o; o.x = pk2(acc[0], acc[1]); o.y = pk2(acc[2], acc[3]);
            *(GAS v2u*)(AO + (size_t)(b * 8192 + kk1 + 128 * k2) * 1024 + 768 + g * 64 + 16 * ct + 4 * fq) = o; }
        __syncthreads();
    }
#undef FB_LOAD
}

#define CAS __attribute__((address_space(4)))
#define PH_ARGS const CAS Args* ap = (const CAS Args*)__builtin_amdgcn_kernarg_segment_ptr(); asm volatile("" : "+s"(ap)); unsigned char* const ws = ap->ws; (void)ws
#define P_SS ((float*)(ws + WS_SS))
#define P_WB(l) ((bf16*)(ws + WS_W) + (size_t)((l) & 1) * W_LAYER_ELEMS)
#define P_XB ((bf16*)(ws + WS_XB))
#define P_Q ((bf16*)(ws + WS_Q))
#define P_K ((bf16*)(ws + WS_K))
#define P_V ((bf16*)(ws + WS_V))
#define P_F ((bf16*)(ws + WS_F))
#define P_G ((bf16*)(ws + WS_G))
#define P_AO ((bf16*)(ws + WS_AO))
#define P_YP ((bf16*)(ws + WS_YP))
#define P_MG ((bf16*)(ws + WS_MG))
#define P_H ((bf16*)(ws + WS_H))
__global__ void __launch_bounds__(NWAVES * 64, 2) fwd_kernel(Args args) {
    extern __shared__ __attribute__((aligned(16))) unsigned char lds_raw[];
    LAS unsigned char* lds = (LAS unsigned char*)lds_raw;
    cg::grid_group grid = cg::this_grid();
    const int G = gridDim.x; const int bx = blockIdx.x; const int vcu = (G % 8 == 0) ? (bx % 8) * (G / 8) + bx / 8 : bx;
    const int lo = args.ph_lo, hi = args.ph_hi;
    if (threadIdx.x < 32) ((volatile LAS unsigned*)(lds + MISC_OFF))[threadIdx.x] = 0u;
    __syncthreads();
    if (threadIdx.x == 0) __hip_atomic_store((unsigned*)(args.ws + WS_XTAB) + blockIdx.x, xb_xcc_id() + 1u, __ATOMIC_RELAXED, __HIP_MEMORY_SCOPE_AGENT);
#define IN(k) (lo <= (k) && (k) < hi)
#define GSEAM(k) do { if (IN(k) && IN((k) + 1)) { PH_ARGS; if (G == 256) group_barrier((unsigned*)(ws + WS_GCNT) + 64 * (bx & 63), (const unsigned*)(ws + WS_XTAB), (volatile LAS unsigned*)(lds + MISC_OFF) + 12, (unsigned*)(ws + WS_BAR) + XB_BAD); else { XcdBarrier xb_; xb_.bar = (unsigned*)(ws + WS_BAR); xb_.x = xb_xcc_id(); xb_.st = (volatile LAS unsigned*)(lds + MISC_OFF) + 8; xcd_barrier(xb_); } } } while (0)
#define OSEAM(k) do { if (IN(k) && IN((k) + 1)) { PH_ARGS; XcdBarrier xb_; xb_.bar = (unsigned*)(ws + WS_BAR); xb_.x = xb_xcc_id(); xb_.st = (volatile LAS unsigned*)(lds + MISC_OFF) + 8; xcd_barrier(xb_, G == 256 && ((volatile LAS unsigned*)(lds + MISC_OFF))[12] == 1u); } } while (0)
#define SEAM(k) do { if (IN(k) && IN((k) + 1)) { PH_ARGS; XcdBarrier xb_; xb_.bar = (unsigned*)(ws + WS_BAR); xb_.x = xb_xcc_id(); xb_.st = (volatile LAS unsigned*)(lds + MISC_OFF) + 8; xcd_barrier(xb_); } } while (0)
#define WAVE_IDS int tid = threadIdx.x; asm volatile("" : "+v"(tid)); const int lane = tid & 63, wave = __builtin_amdgcn_readfirstlane(tid >> 6); const int gw = vcu * NWAVES + wave, NGW = G * NWAVES; (void)lane; (void)gw; (void)NGW
    if (IN(0)) {
        PH_ARGS; WAVE_IDS;
        convert_layer(ap, 0, P_WB(0), (LAS float*)(lds + 57344 + wave * 8448), gw, NGW, lane, 1);
        const float* x = ap->in[0]; float* SS = P_SS; bf16* XB = P_XB;
        for (int m = gw; m < M; m += 2 * NGW) {
            const int mb = (m + NGW < M) ? m + NGW : m;
            const GAS f32x4* xa = (const GAS f32x4*)(x + (size_t)m * D) + lane; const GAS f32x4* xc = (const GAS f32x4*)(x + (size_t)mb * D) + lane;
            f32x4 va[4], vb[4]; float sa = 0.f, sb = 0.f;
#pragma unroll
            for (int j = 0; j < 4; ++j) va[j] = xa[64 * j];
#pragma unroll
            for (int j = 0; j < 4; ++j) vb[j] = xc[64 * j];
#pragma unroll
            for (int j = 0; j < 4; ++j) { sa += pg8::hsum4(va[j] * va[j]); sb += pg8::hsum4(vb[j] * vb[j]); }
            sa = wave_sum(sa); sb = wave_sum(sb);
            GAS v2u* oa = (GAS v2u*)(XB + (size_t)m * D) + lane; GAS v2u* ob = (GAS v2u*)(XB + (size_t)mb * D) + lane;
#pragma unroll
            for (int j = 0; j < 4; ++j) { v2u o; o.x = pk2(va[j][0], va[j][1]); o.y = pk2(va[j][2], va[j][3]); oa[64 * j] = o; }
            if (lane < 16) SS[(size_t)m * 16 + lane] = (lane == 0) ? sa : 0.f;
            if (mb != m) {
#pragma unroll
                for (int j = 0; j < 4; ++j) { v2u o; o.x = pk2(vb[j][0], vb[j][1]); o.y = pk2(vb[j][2], vb[j][3]); ob[64 * j] = o; }
                if (lane < 16) SS[(size_t)mb * 16 + lane] = (lane == 0) ? sb : 0.f;
            }
        }
        if (blockIdx.x == 0) { unsigned* bw = (unsigned*)(ws + WS_BAR); for (int i = tid; i < XCD_BAR_WORDS; i += NWAVES * 64) bw[i] = 0u; }
        if (blockIdx.x == 0 && tid < DEPTH) ((unsigned*)(ws + WS_CNT))[64 * tid] = 0u;
        if (blockIdx.x == 0 && tid < 64) ((unsigned*)(ws + WS_GCNT))[64 * tid] = 0u;
    }
    if (IN(0) && IN(1)) {
        grid.sync();
        PH_ARGS; if (threadIdx.x == 0) (void)xb_add((unsigned*)(ws + WS_BAR) + XB_XCNT(xb_xcc_id()), 1u);
    }
#pragma unroll 1
    for (int l = 0; l < DEPTH; ++l) {
        const int pb = 1 + 7 * l;
        if (IN(pb)) {
            PH_ARGS;
            const pg8::PG8_LAS_F* rl = nullptr;
            if (G == 256) {
                const int pm_ = (bx & 7) * 8 + ((bx >> 3) & 7); const int t_ = threadIdx.x;
                if (t_ < 256) ((LAS float*)(lds + RSTD_OFF))[t_] = pg8::row_rstd(P_SS, pm_ * 256 + t_);
                __syncthreads(); rl = (const pg8::PG8_LAS_F*)(lds + RSTD_OFF);
            }
            pg8::Gemm g{P_XB, P_WB(l) + WO_IN, M, INW, D, D, D}; pg8::StaticOrder S; S.init(M, INW, G, bx);
            pg8::EpiInProj E{P_SS, P_Q, P_K, P_V, P_F, P_G, ap->in[4] + l * 64, ap->in[5] + l * 64, ap->in[3] + l * 2048, rl};
            pg8::gemm_phase<pg8::EpiInProj, pg8::StaticOrder, true, true>(lds, g, S, E);
            {
                WAVE_IDS; const int rem = ((M / 256) * (INW / 256)) % G;
                if (rem == 0) convert_layer(ap, l, P_WB(l), (LAS float*)(lds + 57344 + wave * 8448), gw, NGW, lane, 2);
                else if (bx >= rem) convert_layer(ap, l, P_WB(l), (LAS float*)(lds + 57344 + wave * 8448), (bx - rem) * NWAVES + wave, (G - rem) * NWAVES, lane, 2);
            }
        }
        SEAM(pb);
        if (IN(pb + 2)) {
            PH_ARGS; WAVE_IDS;
            unsigned* cnt = (unsigned*)(ws + WS_CNT) + 64 * l;
            fourier_a_phase(lds, P_F, P_YP, vcu, G, tid);
            asm volatile("s_waitcnt vmcnt(0)" ::: "memory"); __syncthreads();
            if (tid == 0) { __builtin_amdgcn_fence(__ATOMIC_RELEASE, "agent"); asm volatile("s_waitcnt vmcnt(0)" ::: "memory"); (void)xb_add(cnt, 1u); }
            if (l + 1 < DEPTH) convert_layer(ap, l + 1, P_WB(l + 1), (LAS float*)(lds + 57344 + wave * 8448), gw, NGW, lane, 1);
            __syncthreads();
            const attn_body::AttnTensors AT{(const attn_body::bf16*)P_Q, (const attn_body::bf16*)P_K, (const attn_body::bf16*)P_V, (attn_body::bf16*)P_AO};
            attn_body::attn_phase<8>((char*)lds_raw, AT, vcu, G);
            if (tid == 0) { unsigned sp = 0; while (xb_ld(cnt) < (unsigned)G) { __builtin_amdgcn_s_sleep(2); if (++sp > (1u << 24)) break; }
                __builtin_amdgcn_fence(__ATOMIC_ACQUIRE, "agent"); asm volatile("s_waitcnt vmcnt(0)" ::: "memory"); }
            __syncthreads();
            fourier_b_phase(lds, P_YP, P_AO, vcu, G, tid);
        }
        SEAM(pb + 2);
        if (IN(pb + 3)) {
            PH_ARGS;
            pg8::Gemm g{P_AO, P_WB(l) + WO_AB, M, D, D, D, D}; pg8::StaticOrder S; S.init(M, D, G, bx);
            pg8::EpiBranchZ E{P_G, P_MG}; pg8::gemm_phase<pg8::EpiBranchZ, pg8::StaticOrder, true, true>(lds, g, S, E);
        }
        GSEAM(pb + 3);
        if (IN(pb + 4)) {
            PH_ARGS;
            pg8::Gemm g{P_MG, P_WB(l) + WO_OUT, M, D, D, D, D}; pg8::StaticOrder S; S.init(M, D, G, bx);
            pg8::EpiRes E{P_XB, P_SS}; pg8::gemm_phase<pg8::EpiRes, pg8::StaticOrder, true, true>(lds, g, S, E);
        }
        OSEAM(pb + 4);
        if (IN(pb + 5)) {
            PH_ARGS;
            const pg8::PG8_LAS_F* rl = nullptr;
            if (G == 256) {
                const int pm_ = (bx & 7) * 8 + ((bx >> 3) & 7); const int t_ = threadIdx.x;
                if (t_ < 256) ((LAS float*)(lds + RSTD_OFF))[t_] = pg8::row_rstd(P_SS, pm_ * 256 + t_);
                __syncthreads(); rl = (const pg8::PG8_LAS_F*)(lds + RSTD_OFF);
            }
            pg8::Gemm g{P_XB, P_WB(l) + WO_UP, M, FF, D, D, D}; pg8::StaticOrder S; S.init(M, FF, G, bx);
            pg8::EpiUp E{P_SS, P_H, rl}; pg8::gemm_phase<pg8::EpiUp, pg8::StaticOrder, true, true>(lds, g, S, E);
        }
        GSEAM(pb + 5);
        if (IN(pb + 6)) {
            PH_ARGS;
            pg8::Gemm g{P_H, P_WB(l) + WO_DOWN, M, D, FF, FF, FF}; pg8::StaticOrder S; S.init(M, D, G, bx);
            if (l == DEPTH - 1 && G == 256 && IN(N_PHASES - 1)) {
                pg8::EpiResFinal E{P_XB, P_SS, ap->out, ap->in[12], (unsigned*)(ws + WS_GCNT) + 64 * (bx & 63), (pg8::PG8_LAS_F*)(lds + RSTD_OFF)};
                pg8::gemm_phase<pg8::EpiResFinal, pg8::StaticOrder, true, true>(lds, g, S, E);
            } else {
                pg8::EpiRes E{P_XB, P_SS}; pg8::gemm_phase<pg8::EpiRes, pg8::StaticOrder, true, true>(lds, g, S, E);
            }
        }
        if (!(l == DEPTH - 1 && G == 256)) OSEAM(pb + 6);
    }
    if (IN(N_PHASES - 1) && G != 256) {
        PH_ARGS; WAVE_IDS;
        const float* gf = ap->in[12]; float* O = ap->out; const bf16* XBp = P_XB;
        f32x4 gv[2][2];
#pragma unroll
        for (int j = 0; j < 2; ++j) { gv[j][0] = *((const GAS f32x4*)gf + 2 * (lane + 64 * j)); gv[j][1] = *((const GAS f32x4*)gf + 2 * (lane + 64 * j) + 1); }
        for (int m = gw; m < M; m += 2 * NGW) {
            const int mb = (m + NGW < M) ? m + NGW : m;
            const GAS v4u* xa = (const GAS v4u*)(XBp + (size_t)m * D) + lane; const GAS v4u* xc = (const GAS v4u*)(XBp + (size_t)mb * D) + lane;
            v4u wa[2], wb[2];
#pragma unroll
            for (int j = 0; j < 2; ++j) { wa[j] = xa[64 * j]; wb[j] = xc[64 * j]; }
            f32x4 va[2][2], vb[2][2]; float sa = 0.f, sb = 0.f;
#pragma unroll
            for (int j = 0; j < 2; ++j) {
                va[j][0] = (f32x4){pg8::bf_lo(wa[j].x), pg8::bf_hi(wa[j].x), pg8::bf_lo(wa[j].y), pg8::bf_hi(wa[j].y)}; va[j][1] = (f32x4){pg8::bf_lo(wa[j].z), pg8::bf_hi(wa[j].z), pg8::bf_lo(wa[j].w), pg8::bf_hi(wa[j].w)};
                vb[j][0] = (f32x4){pg8::bf_lo(wb[j].x), pg8::bf_hi(wb[j].x), pg8::bf_lo(wb[j].y), pg8::bf_hi(wb[j].y)}; vb[j][1] = (f32x4){pg8::bf_lo(wb[j].z), pg8::bf_hi(wb[j].z), pg8::bf_lo(wb[j].w), pg8::bf_hi(wb[j].w)};
                sa += pg8::hsum4(va[j][0] * va[j][0]) + pg8::hsum4(va[j][1] * va[j][1]); sb += pg8::hsum4(vb[j][0] * vb[j][0]) + pg8::hsum4(vb[j][1] * vb[j][1]); }
            const float ra = rsqrtf(wave_sum(sa) * (1.0f / D) + 1e-6f), rb = rsqrtf(wave_sum(sb) * (1.0f / D) + 1e-6f);
            GAS f32x4* oa = (GAS f32x4*)(O + (size_t)m * D); GAS f32x4* ob = (GAS f32x4*)(O + (size_t)mb * D);
#pragma unroll
            for (int j = 0; j < 2; ++j) { oa[2 * (lane + 64 * j)] = va[j][0] * ra * gv[j][0]; oa[2 * (lane + 64 * j) + 1] = va[j][1] * ra * gv[j][1]; }
            if (mb != m) {
#pragma unroll
                for (int j = 0; j < 2; ++j) { ob[2 * (lane + 64 * j)] = vb[j][0] * rb * gv[j][0]; ob[2 * (lane + 64 * j) + 1] = vb[j][1] * rb * gv[j][1]; }
            }
        }
    }
#undef IN
#undef SEAM
}

extern "C" void kernel_launch(void* const* d_in, const int* in_sizes, int n_in, void* d_out, int out_size, void* d_ws, size_t ws_size, hipStream_t stream) {
    static int grid = 0;
    if (grid == 0) {
        if (n_in != 13 || in_sizes[0] != M * D || out_size != M * D || ws_size < WS_END) { fprintf(stderr, "kernel_launch: unexpected shapes (n_in %d, in0 %d, out %d, ws %zu)\n", n_in, n_in > 0 ? in_sizes[0] : -1, out_size, ws_size); grid = -1; return; }
        int dev = 0, cus = 0, per_cu = 0;
        if (hipGetDevice(&dev) != hipSuccess || hipDeviceGetAttribute(&cus, hipDeviceAttributeMultiprocessorCount, dev) != hipSuccess) { grid = -1; return; }
        if (hipFuncSetAttribute((const void*)fwd_kernel, hipFuncAttributeMaxDynamicSharedMemorySize, LDS_BYTES) != hipSuccess) { fprintf(stderr, "kernel_launch: hipFuncSetAttribute failed\n"); grid = -1; return; }
        if (hipOccupancyMaxActiveBlocksPerMultiprocessor(&per_cu, (const void*)fwd_kernel, NWAVES * 64, LDS_BYTES) != hipSuccess || per_cu < 1) per_cu = 1;
        (void)hipGetLastError();
        grid = cus * per_cu;
    }
    if (grid < 0) return;
    Args a{};
    for (int i = 0; i < 13; ++i) a.in[i] = (const float*)d_in[i];
    a.out = (float*)d_out; a.ws = (unsigned char*)d_ws;
#if MK_PER_PHASE
    for (int p = 0; p < N_PHASES; ++p) { a.ph_lo = p; a.ph_hi = p + 1; hipLaunchKernelGGL(fwd_kernel, dim3(grid), dim3(NWAVES * 64), LDS_BYTES, stream, a); }
#else
    a.ph_lo = 0; a.ph_hi = N_PHASES;
    void* kargs[] = {&a};
    const hipError_t e = hipLaunchCooperativeKernel((const void*)fwd_kernel, dim3(grid), dim3(NWAVES * 64), kargs, LDS_BYTES, stream);
    if (e != hipSuccess) fprintf(stderr, "kernel_launch: cooperative launch failed: %s (grid %d)\n", hipGetErrorString(e), grid);
#endif
}
```

```cpp
#include <hip/hip_runtime.h>
#include <hip/hip_cooperative_groups.h>
#include <cstdio>
#include <cstdint>
namespace cg = cooperative_groups;
namespace pg8 {
#define PG8_LAS __attribute__((address_space(3)))
typedef unsigned short bf16_t;
typedef short bf16x8 __attribute__((ext_vector_type(8)));
typedef float f32x4 __attribute__((ext_vector_type(4)));
typedef unsigned u32x4 __attribute__((ext_vector_type(4)));
constexpr int BM = 256, BK = 64, HALF = 128, HTB = HALF * BK * 2  , STAGE_BYTES = 8 * HTB, NXCD = 8, WGM = 8;

__host__ __device__ __forceinline__ int lds_byte(int r, int c) { const int st = (r >> 4) * 2 + (c >> 5), rr = r & 15, cc = c & 31, ob = rr * 64 + cc * 2; return st * 1024 + (ob ^ (((ob >> 9) & 1) << 5)); }
__host__ __device__ __forceinline__ void stage_rc(int b, int& R, int& C) { const int st = b / 1024, sb = b % 1024, swz = sb ^ (((sb >> 9) & 1) << 5); R = (st >> 1) * 16 + swz / 64; C = (st & 1) * 32 + (swz % 64) / 2; }
__host__ __device__ __forceinline__ int perm32(int rho) { const int n = rho >> 4, i = rho & 15; return 8 * (i >> 2) + 4 * n + (i & 3); }

struct Unit { int pm, pn; };
struct Gemm { const bf16_t* A; const bf16_t* Bt; int M, N, K, lda, ldb; };

struct StaticOrder {
    int nM, nN, nwg, G, c;
    __host__ __device__ void init(int M, int N, int G_, int c_) { nM = M / BM; nN = N / BM; nwg = nM * nN; G = G_; c = c_; }
    __host__ __device__ bool next(int i, Unit& u) const {
        const long L = (long)i * G + c; if (L >= nwg) return false;
        int wgid = (int)L; { const int q = nwg / NXCD, r = nwg % NXCD, xcd = wgid % NXCD, off = wgid / NXCD; wgid = (xcd < r ? xcd * (q + 1) : r * (q + 1) + (xcd - r) * q) + off; }
        const int nig = WGM * nN, gid = wgid / nig, fm = gid * WGM, gsz = (nM - fm) < WGM ? (nM - fm) : WGM;
        u.pm = fm + ((wgid % nig) % gsz); u.pn = (wgid % nig) / gsz; return true;
    }
    __device__ __forceinline__ void a_ready(const Unit&) const {}
    __device__ __forceinline__ void done(const Unit&) const {}
};
typedef float f32x2_cv __attribute__((ext_vector_type(2))); typedef __bf16 bf16x2_cv __attribute__((ext_vector_type(2)));
__device__ __forceinline__ unsigned cvt_pk_bf16(float lo, float hi) { f32x2_cv v = {lo, hi}; bf16x2_cv b = __builtin_convertvector(v, bf16x2_cv); return __builtin_bit_cast(unsigned, b); }
typedef float f32x2 __attribute__((ext_vector_type(2)));
typedef PG8_LAS float PG8_LAS_F;
constexpr float RMS_EPS = 1e-6f;
constexpr float ATT_C2 = 0.125f * 1.4426950408889634f;
__device__ __forceinline__ float bf_lo(unsigned w) { return __uint_as_float(w << 16); }
__device__ __forceinline__ float bf_hi(unsigned w) { return __uint_as_float(w & 0xffff0000u); }
__device__ __forceinline__ u32x4 pack8(const f32x4 a, const f32x4 b) { u32x4 w; w.x = cvt_pk_bf16(a[0], a[1]); w.y = cvt_pk_bf16(a[2], a[3]); w.z = cvt_pk_bf16(b[0], b[1]); w.w = cvt_pk_bf16(b[2], b[3]); return w; }
__device__ __forceinline__ float hsum4(const f32x4 a) { return (a[0] + a[1]) + (a[2] + a[3]); }
__device__ __forceinline__ float row_rstd(const float* ss, int row) {
    const f32x4* p = (const f32x4*)(ss + (size_t)row * 16);
    const float s = (hsum4(p[0]) + hsum4(p[1])) + (hsum4(p[2]) + hsum4(p[3]));
    return rsqrtf(s * (1.0f / 1024.0f) + RMS_EPS);
}
__device__ __forceinline__ void rows_scale(const PG8_LAS float* rl, const float* ss, int row0, int lrow, float (&rs)[2][4]) {
    if (rl) {
#pragma unroll
        for (int ai = 0; ai < 2; ++ai)
#pragma unroll
            for (int m = 0; m < 4; ++m) rs[ai][m] = rl[ai * HALF + m * 16 + lrow];
    } else {
#pragma unroll
        for (int ai = 0; ai < 2; ++ai)
#pragma unroll
            for (int m = 0; m < 4; ++m) rs[ai][m] = row_rstd(ss, row0 + ai * HALF + m * 16);
    }
}
struct EpiInProj {
    static constexpr bool PERM = true, AFTER_DRAIN = false; static constexpr int MIDT = 0;
    const float* ss; bf16_t *Q, *Kb, *Vb, *Fb, *G; const float *qg, *kg, *bgate; const PG8_LAS float* rl;
    __device__ __forceinline__ void operator()(const f32x4 (&acc)[2][2][4][2], const Unit& u, int wr, int wc, int fr, int fq) const {
        const int pn = u.pn; int row0 = u.pm * BM + wr * 64 + fr; asm volatile("" : "+v"(row0));
        float rsv[2][4]; rows_scale(rl, ss, row0, wr * 64 + fr, rsv);
        if (pn < 4) {
            const float* gp = (pn < 3) ? qg : kg;
            int fqo = fq; asm volatile("" : "+v"(fqo));
            float ifr[4];
#pragma unroll
            for (int j = 0; j < 4; ++j) ifr[j] = __builtin_amdgcn_exp2f(-(float)(4 * fqo + j) * (13.287712379549449f / 16.0f)) * 0.15915494309189535f;
            const float osc = (pn < 3) ? ATT_C2 : 1.0f;
            bf16_t* dst = (pn < 3) ? Q + (4 * pn + wc) * 64 : Kb + wc * 64; const int pitch = (pn < 3) ? 768 : 256;
#pragma unroll
            for (int ai = 0; ai < 2; ++ai)
#pragma unroll
                for (int m = 0; m < 4; ++m) {
                    const int row = row0 + ai * HALF + m * 16; const float rs = rsv[ai][m];
                    const int t = row & 8191; const float prow = (float)(t >> 6), pcol = (float)(t & 63);
                    float q = 0.f;
#pragma unroll
                    for (int bj = 0; bj < 2; ++bj)
#pragma unroll
                        for (int n = 0; n < 2; ++n) q += hsum4(acc[ai][bj][m][n] * acc[ai][bj][m][n]);
                    q += __shfl_xor(q, 16); q += __shfl_xor(q, 32);
                    const float hr = rs * rsqrtf(q * rs * rs * (1.0f / 64.0f) + RMS_EPS) * osc;
#pragma unroll
                    for (int bj = 0; bj < 2; ++bj) {
                        const float pos = bj ? pcol : prow; f32x4 o[2];
#pragma unroll
                        for (int n = 0; n < 2; ++n) {
                            const f32x4 gvv = *(const f32x4*)(gp + 32 * bj + 8 * fq + 4 * n); const f32x4 xv = acc[ai][bj][m][n] * hr * gvv;
#pragma unroll
                            for (int e = 0; e < 2; ++e) {
                                const float rev = pos * ifr[2 * n + e];
                                const float c = __builtin_amdgcn_cosf(rev), s = __builtin_amdgcn_sinf(rev);
                                o[n][2 * e] = xv[2 * e] * c - xv[2 * e + 1] * s; o[n][2 * e + 1] = xv[2 * e] * s + xv[2 * e + 1] * c;
                            }
                        }
                        *(u32x4*)(dst + (size_t)row * pitch + 32 * bj + 8 * fq) = pack8(o[0], o[1]);
                    }
                    asm volatile("" ::: "memory");
                }
        } else if (pn < 6) {
            bf16_t* dst = (pn == 4) ? Vb : Fb;
#pragma unroll
            for (int ai = 0; ai < 2; ++ai)
#pragma unroll
                for (int m = 0; m < 4; ++m) {
                    const int row = row0 + ai * HALF + m * 16; const float rs = rsv[ai][m];
#pragma unroll
                    for (int bj = 0; bj < 2; ++bj) *(u32x4*)(dst + (size_t)row * 256 + 128 * bj + 32 * wc + 8 * fq) = pack8(acc[ai][bj][m][0] * rs, acc[ai][bj][m][1] * rs);
                    asm volatile("" ::: "memory");
                }
        } else {
            int gc0 = (pn - 6) * 256 + 32 * wc + 8 * fq; asm volatile("" : "+v"(gc0));
            f32x4 bv[2][2];
#pragma unroll
            for (int bj = 0; bj < 2; ++bj)
#pragma unroll
                for (int n = 0; n < 2; ++n) bv[bj][n] = *(const f32x4*)(bgate + gc0 + 128 * bj + 4 * n);
#pragma unroll
            for (int ai = 0; ai < 2; ++ai)
#pragma unroll
                for (int m = 0; m < 4; ++m) {
                    const int row = row0 + ai * HALF + m * 16; const float rs = rsv[ai][m];
#pragma unroll
                    for (int bj = 0; bj < 2; ++bj) { f32x4 o[2];
#pragma unroll
                        for (int n = 0; n < 2; ++n) { const f32x4 x = acc[ai][bj][m][n] * rs + bv[bj][n];
#pragma unroll
                            for (int e = 0; e < 4; ++e) o[n][e] = __builtin_amdgcn_rcpf(1.0f + __builtin_amdgcn_exp2f(-1.4426950408889634f * x[e])); }
                        *(u32x4*)(G + (size_t)row * 2048 + gc0 + 128 * bj) = pack8(o[0], o[1]); }
                    asm volatile("" ::: "memory");
                }
        }
    }
};
template <int MODE> struct EpiBranch {
    static constexpr bool PERM = true, AFTER_DRAIN = false; static constexpr int MIDT = 0;
    const bf16_t* G; bf16_t* MG;
    __device__ __forceinline__ void operator()(const f32x4 (&acc)[2][2][4][2], const Unit& u, int wr, int wc, int fr, int fq) const {
        int row0 = u.pm * BM + wr * 64 + fr, col0 = u.pn * BM + 32 * wc + 8 * fq; asm volatile("" : "+v"(row0), "+v"(col0));
#pragma unroll
        for (int ai = 0; ai < 2; ++ai)
#pragma unroll
            for (int m = 0; m < 4; ++m) {
                const int row = row0 + ai * HALF + m * 16;
#pragma unroll
                for (int bj = 0; bj < 2; ++bj) {
                    const int col = col0 + 128 * bj;
                    const u32x4 gw = *(const u32x4*)(G + (size_t)row * 2048 + (MODE == 0 ? 1024 : 0) + col);
                    f32x4 o0, o1; const f32x4 a0 = acc[ai][bj][m][0], a1 = acc[ai][bj][m][1];
                    o0[0] = bf_lo(gw.x) * a0[0]; o0[1] = bf_hi(gw.x) * a0[1]; o0[2] = bf_lo(gw.y) * a0[2]; o0[3] = bf_hi(gw.y) * a0[3];
                    o1[0] = bf_lo(gw.z) * a1[0]; o1[1] = bf_hi(gw.z) * a1[1]; o1[2] = bf_lo(gw.w) * a1[2]; o1[3] = bf_hi(gw.w) * a1[3];
                    bf16_t* p = MG + (size_t)row * 1024 + col;
                    if (MODE == 1) { const u32x4 tw = *(const u32x4*)p;
                        o0[0] += bf_lo(tw.x); o0[1] += bf_hi(tw.x); o0[2] += bf_lo(tw.y); o0[3] += bf_hi(tw.y);
                        o1[0] += bf_lo(tw.z); o1[1] += bf_hi(tw.z); o1[2] += bf_lo(tw.w); o1[3] += bf_hi(tw.w); }
                    *(u32x4*)p = pack8(o0, o1);
                }
                asm volatile("" ::: "memory");
            }
    }
};
struct EpiBranchZ {
    static constexpr bool PERM = true, AFTER_DRAIN = false; static constexpr int MIDT = 12;
    const bf16_t* G; bf16_t* MG;
    __device__ __forceinline__ void mid(f32x4 (&acc)[2][2][4][2], const Unit& u, int wr, int wc, int fr, int fq) const {
        int row0 = u.pm * BM + wr * 64 + fr, col0 = u.pn * BM + 32 * wc + 8 * fq; asm volatile("" : "+v"(row0), "+v"(col0));
#pragma unroll
        for (int ai = 0; ai < 2; ++ai)
#pragma unroll
            for (int m = 0; m < 4; ++m) {
                const int row = row0 + ai * HALF + m * 16;
#pragma unroll
                for (int bj = 0; bj < 2; ++bj) {
                    const bf16_t* gp = G + (size_t)row * 2048 + col0 + 128 * bj;
                    const u32x4 ga = *(const u32x4*)gp, gf = *(const u32x4*)(gp + 1024);
                    f32x4& a0 = acc[ai][bj][m][0]; f32x4& a1 = acc[ai][bj][m][1];
#define BZ_R(A, F) ((A) * __builtin_amdgcn_rcpf(fmaxf((F), 1e-6f)))
                    a0[0] *= BZ_R(bf_lo(ga.x), bf_lo(gf.x)); a0[1] *= BZ_R(bf_hi(ga.x), bf_hi(gf.x)); a0[2] *= BZ_R(bf_lo(ga.y), bf_lo(gf.y)); a0[3] *= BZ_R(bf_hi(ga.y), bf_hi(gf.y));
                    a1[0] *= BZ_R(bf_lo(ga.z), bf_lo(gf.z)); a1[1] *= BZ_R(bf_hi(ga.z), bf_hi(gf.z)); a1[2] *= BZ_R(bf_lo(ga.w), bf_lo(gf.w)); a1[3] *= BZ_R(bf_hi(ga.w), bf_hi(gf.w));
#undef BZ_R
                }
                asm volatile("" ::: "memory");
            }
    }
    __device__ __forceinline__ void operator()(f32x4 (&acc)[2][2][4][2], const Unit& u, int wr, int wc, int fr, int fq) const {
        int row0 = u.pm * BM + wr * 64 + fr, col0 = u.pn * BM + 32 * wc + 8 * fq; asm volatile("" : "+v"(row0), "+v"(col0));
#pragma unroll
        for (int ai = 0; ai < 2; ++ai)
#pragma unroll
            for (int m = 0; m < 4; ++m) {
                int rb = row0 + ai * HALF + m * 16; asm volatile("" : "+v"(rb));
                const bf16_t* gp = G + (size_t)rb * 2048 + 1024 + col0;
                const u32x4 g0 = *(const u32x4*)gp, g1 = *(const u32x4*)(gp + 128);
#define BZ_M(A, GW) { f32x4& a0 = A[0]; f32x4& a1 = A[1]; a0[0] *= fmaxf(bf_lo(GW.x), 1e-6f); a0[1] *= fmaxf(bf_hi(GW.x), 1e-6f); a0[2] *= fmaxf(bf_lo(GW.y), 1e-6f); a0[3] *= fmaxf(bf_hi(GW.y), 1e-6f); \
                      a1[0] *= fmaxf(bf_lo(GW.z), 1e-6f); a1[1] *= fmaxf(bf_hi(GW.z), 1e-6f); a1[2] *= fmaxf(bf_lo(GW.w), 1e-6f); a1[3] *= fmaxf(bf_hi(GW.w), 1e-6f); }
                BZ_M(acc[ai][0][m], g0) BZ_M(acc[ai][1][m], g1)
#undef BZ_M
                asm volatile("" : "+v"(acc[ai][0][m][0]), "+v"(acc[ai][0][m][1]), "+v"(acc[ai][1][m][0]), "+v"(acc[ai][1][m][1]) :: "memory");
            }
#pragma unroll
        for (int ai = 0; ai < 2; ++ai)
#pragma unroll
            for (int m = 0; m < 4; ++m) {
                int row = row0 + ai * HALF + m * 16; asm volatile("" : "+v"(row));
                bf16_t* p = MG + (size_t)row * 1024 + col0;
                *(u32x4*)p = pack8(acc[ai][0][m][0], acc[ai][0][m][1]); *(u32x4*)(p + 128) = pack8(acc[ai][1][m][0], acc[ai][1][m][1]);
            }
    }
};
struct EpiRes {
    static constexpr bool PERM = true, AFTER_DRAIN = false; static constexpr int MIDT = 0;
    bf16_t* xb; float* ss;
    __device__ __forceinline__ void operator()(f32x4 (&acc)[2][2][4][2], const Unit& u, int wr, int wc, int fr, int fq) const {
        int row0 = u.pm * BM + wr * 64 + fr, col0 = u.pn * BM + 32 * wc + 8 * fq; asm volatile("" : "+v"(row0), "+v"(col0));
#pragma unroll
        for (int ai = 0; ai < 2; ++ai)
#pragma unroll
          for (int m = 0; m < 4; ++m) {
            int rb = row0 + ai * HALF + 16 * m; asm volatile("" : "+v"(rb));
            const bf16_t* p = xb + (size_t)rb * 1024 + col0;
            const u32x4 b0 = *(const u32x4*)p, b1 = *(const u32x4*)(p + 128);
            f32x4& a00 = acc[ai][0][m][0]; f32x4& a01 = acc[ai][0][m][1]; f32x4& a10 = acc[ai][1][m][0]; f32x4& a11 = acc[ai][1][m][1];
            a00[0] += bf_lo(b0.x); a00[1] += bf_hi(b0.x); a00[2] += bf_lo(b0.y); a00[3] += bf_hi(b0.y); a01[0] += bf_lo(b0.z); a01[1] += bf_hi(b0.z); a01[2] += bf_lo(b0.w); a01[3] += bf_hi(b0.w);
            a10[0] += bf_lo(b1.x); a10[1] += bf_hi(b1.x); a10[2] += bf_lo(b1.y); a10[3] += bf_hi(b1.y); a11[0] += bf_lo(b1.z); a11[1] += bf_hi(b1.z); a11[2] += bf_lo(b1.w); a11[3] += bf_hi(b1.w);
            asm volatile("" : "+v"(acc[ai][0][m][0]), "+v"(acc[ai][0][m][1]), "+v"(acc[ai][1][m][0]), "+v"(acc[ai][1][m][1]) :: "memory"); }
#pragma unroll
        for (int ai = 0; ai < 2; ++ai)
#pragma unroll
            for (int m = 0; m < 4; ++m) {
                int row = row0 + ai * HALF + m * 16; asm volatile("" : "+v"(row)); float q = 0.f;
                bf16_t* pb = xb + (size_t)row * 1024 + col0;
#pragma unroll
                for (int bj = 0; bj < 2; ++bj) {
                    const f32x4 o0 = acc[ai][bj][m][0], o1 = acc[ai][bj][m][1];
                    *(u32x4*)(pb + 128 * bj) = pack8(o0, o1);
                    q += hsum4(o0 * o0) + hsum4(o1 * o1);
                }
                q += __shfl_xor(q, 16); q += __shfl_xor(q, 32);
                if (fq == 0) ss[(size_t)row * 16 + 4 * u.pn + wc] = q;
                asm volatile("" ::: "memory");
            }
    }
};
struct EpiResFinal {
    static constexpr bool PERM = true, AFTER_DRAIN = false; static constexpr int MIDT = 0;
    const bf16_t* xb; float* ss; float* out; const float* gfin; unsigned* gcnt; PG8_LAS float* tab;
    __device__ __forceinline__ void operator()(f32x4 (&acc)[2][2][4][2], const Unit& u, int wr, int wc, int fr, int fq) const {
        int row0 = u.pm * BM + wr * 64 + fr, col0 = u.pn * BM + 32 * wc + 8 * fq; asm volatile("" : "+v"(row0), "+v"(col0));
#pragma unroll
        for (int ai = 0; ai < 2; ++ai)
#pragma unroll
          for (int m = 0; m < 4; ++m) {
            int rb = row0 + ai * HALF + 16 * m; asm volatile("" : "+v"(rb));
            const bf16_t* p = xb + (size_t)rb * 1024 + col0;
            const u32x4 b0 = *(const u32x4*)p, b1 = *(const u32x4*)(p + 128);
            f32x4& a00 = acc[ai][0][m][0]; f32x4& a01 = acc[ai][0][m][1]; f32x4& a10 = acc[ai][1][m][0]; f32x4& a11 = acc[ai][1][m][1];
            a00[0] += bf_lo(b0.x); a00[1] += bf_hi(b0.x); a00[2] += bf_lo(b0.y); a00[3] += bf_hi(b0.y); a01[0] += bf_lo(b0.z); a01[1] += bf_hi(b0.z); a01[2] += bf_lo(b0.w); a01[3] += bf_hi(b0.w);
            a10[0] += bf_lo(b1.x); a10[1] += bf_hi(b1.x); a10[2] += bf_lo(b1.y); a10[3] += bf_hi(b1.y); a11[0] += bf_lo(b1.z); a11[1] += bf_hi(b1.z); a11[2] += bf_lo(b1.w); a11[3] += bf_hi(b1.w);
            asm volatile("" : "+v"(acc[ai][0][m][0]), "+v"(acc[ai][0][m][1]), "+v"(acc[ai][1][m][0]), "+v"(acc[ai][1][m][1]) :: "memory"); }
#pragma unroll
        for (int ai = 0; ai < 2; ++ai)
#pragma unroll
            for (int m = 0; m < 4; ++m) {
                int row = row0 + ai * HALF + m * 16; asm volatile("" : "+v"(row)); float q = 0.f;
#pragma unroll
                for (int bj = 0; bj < 2; ++bj) q += hsum4(acc[ai][bj][m][0] * acc[ai][bj][m][0]) + hsum4(acc[ai][bj][m][1] * acc[ai][bj][m][1]);
                q += __shfl_xor(q, 16); q += __shfl_xor(q, 32);
                if (fq == 0) ss[(size_t)row * 16 + 4 * u.pn + wc] = q;
            }
        asm volatile("s_waitcnt vmcnt(0)" ::: "memory");
        __syncthreads();
        if (threadIdx.x == 0) {
            __builtin_amdgcn_fence(__ATOMIC_RELEASE, "agent"); asm volatile("s_waitcnt vmcnt(0)" ::: "memory");
            const unsigned old = __hip_atomic_fetch_add(gcnt, 1u, __ATOMIC_RELAXED, __HIP_MEMORY_SCOPE_AGENT), target = (old / 4u + 1u) * 4u; unsigned sp = 0;
            while (__hip_atomic_load(gcnt, __ATOMIC_RELAXED, __HIP_MEMORY_SCOPE_AGENT) < target) { __builtin_amdgcn_s_sleep(1); if (++sp > (1u << 24)) break; }
            __builtin_amdgcn_fence(__ATOMIC_ACQUIRE, "agent"); asm volatile("s_waitcnt vmcnt(0)" ::: "memory");
        }
        __syncthreads();
        if (threadIdx.x < 256) tab[threadIdx.x] = row_rstd(ss, u.pm * BM + (int)threadIdx.x);
        __syncthreads();
        float rsv[2][4];
#pragma unroll
        for (int ai = 0; ai < 2; ++ai)
#pragma unroll
            for (int m = 0; m < 4; ++m) rsv[ai][m] = tab[ai * HALF + wr * 64 + m * 16 + fr];
        f32x4 gv[2][2];
#pragma unroll
        for (int bj = 0; bj < 2; ++bj)
#pragma unroll
            for (int n = 0; n < 2; ++n) { gv[bj][n] = *(const f32x4*)(gfin + col0 + 128 * bj + 4 * n); asm volatile("" : "+v"(gv[bj][n])); }
        asm volatile("" ::: "memory");
#pragma unroll
        for (int ai = 0; ai < 2; ++ai)
#pragma unroll
            for (int m = 0; m < 4; ++m) {
                int row = row0 + ai * HALF + m * 16; asm volatile("" : "+v"(row)); const float rs = rsv[ai][m];
                float* po = out + (size_t)row * 1024 + col0;
#pragma unroll
                for (int bj = 0; bj < 2; ++bj) { *(f32x4*)(po + 128 * bj) = acc[ai][bj][m][0] * rs * gv[bj][0]; *(f32x4*)(po + 128 * bj + 4) = acc[ai][bj][m][1] * rs * gv[bj][1]; }
            }
    }
};
struct EpiUp {
    static constexpr bool PERM = true, AFTER_DRAIN = false; static constexpr int MIDT = 0;
    const float* ss; bf16_t* H; const PG8_LAS float* rl;
    __device__ __forceinline__ void operator()(const f32x4 (&acc)[2][2][4][2], const Unit& u, int wr, int wc, int fr, int fq) const {
        int row0 = u.pm * BM + wr * 64 + fr, col0 = u.pn * BM + 32 * wc + 8 * fq; asm volatile("" : "+v"(row0), "+v"(col0));
        float rsv[2][4]; rows_scale(rl, ss, row0, wr * 64 + fr, rsv);
#pragma unroll
        for (int ai = 0; ai < 2; ++ai)
#pragma unroll
            for (int m = 0; m < 4; ++m) {
                const int row = row0 + ai * HALF + m * 16; const float rs = rsv[ai][m];
#pragma unroll
                for (int bj = 0; bj < 2; ++bj) { f32x4 o[2];
#pragma unroll
                    for (int n = 0; n < 2; ++n) { const f32x4 x = acc[ai][bj][m][n] * rs;
#pragma unroll
                        for (int e = 0; e < 4; ++e) { const float r = fmaxf(x[e], 0.f); o[n][e] = r * r; } }
                    *(u32x4*)(H + (size_t)row * 4096 + col0 + 128 * bj) = pack8(o[0], o[1]); }
                asm volatile("" ::: "memory");
            }
    }
};
template <class Epi, class Sched, bool ALIGN_EPI = false, bool SP2 = false>
__device__ __forceinline__ void gemm_phase(PG8_LAS unsigned char* lds, const Gemm g, const Sched& S, const Epi& E) {
    int tid_o = threadIdx.x; asm volatile("" : "+v"(tid_o));
    const int tid = tid_o, wid = __builtin_amdgcn_readfirstlane(tid >> 6), lane = tid & 63, wr = wid >> 2, wc = wid & 3, fr = lane & 15, fq = lane >> 4;
    const int K = g.K, nt = K / BK;
    unsigned voffA[2], voffB[2];
#pragma unroll
    for (int i = 0; i < 2; ++i) { int R, C; stage_rc(tid * 16 + i * 8192, R, C); const int Rb = Epi::PERM ? ((R & ~31) + perm32(R & 31)) : R;
        voffA[i] = (unsigned)(R * g.lda + C) * 2u; voffB[i] = (unsigned)(Rb * g.ldb + C) * 2u; }
    const size_t kstep = (size_t)(BK * 2);
    const size_t hstepA = (size_t)HALF * g.lda * 2, hstepB = (size_t)HALF * g.ldb * 2;
    const size_t tstepA = 2 * hstepA, tstepB = 2 * hstepB;
    const unsigned ldsw = (unsigned)wid * 1024u;
    const int aoff = lds_byte(wr * 64 + fr, fq * 8), boff = lds_byte(wc * 32 + fr, fq * 8);
#define PG8_SA(b, h) (((b) * 2 + (h)) * HTB)
#define PG8_SB(b, h) ((4 + (b) * 2 + (h)) * HTB)
#define PG8_STAGE(bufoff, gbase, voff) do { _Pragma("unroll") for (int _i = 0; _i < 2; ++_i) \
        __builtin_amdgcn_global_load_lds((const unsigned*)((const char*)(gbase) + (voff)[_i]), (PG8_LAS unsigned*)(lds + (bufoff) + ldsw + _i * 8192), 16, 0, 0); } while (0)
#define PG8_LDA(dst, b, h) do { _Pragma("unroll") for (int m = 0; m < 4; ++m) _Pragma("unroll") for (int k = 0; k < 2; ++k) dst[m][k] = *(const PG8_LAS bf16x8*)(lds + PG8_SA(b, h) + aoff + m * 2048 + k * 1024); } while (0)
#define PG8_LDB(dst, b, h) do { _Pragma("unroll") for (int n = 0; n < 2; ++n) _Pragma("unroll") for (int k = 0; k < 2; ++k) dst[n][k] = *(const PG8_LAS bf16x8*)(lds + PG8_SB(b, h) + boff + n * 2048 + k * 1024); } while (0)
#define PG8_MMA(ai, bj, At, Bt) do { __builtin_amdgcn_s_setprio(1); _Pragma("unroll") for (int m = 0; m < 4; ++m) _Pragma("unroll") for (int n = 0; n < 2; ++n) _Pragma("unroll") for (int k = 0; k < 2; ++k) \
        acc[ai][bj][m][n] = __builtin_amdgcn_mfma_f32_16x16x32_bf16(Bt[n][k], At[m][k], acc[ai][bj][m][n], 0, 0, 0); __builtin_amdgcn_s_setprio(0); } while (0)
#define PG8_WAIT_V(n) asm volatile("s_waitcnt vmcnt(" #n ")" ::: "memory")
#define PG8_WAIT_L(n) asm volatile("s_waitcnt lgkmcnt(" #n ")" ::: "memory")
#define PG8_BAR __builtin_amdgcn_s_barrier()
#define PG8_SCHED __builtin_amdgcn_sched_barrier(0)
    Unit cur, nxt; int ui = 0;
    if (!S.next(0, cur)) return;
    f32x4 acc[2][2][4][2];
#pragma unroll
    for (int a = 0; a < 2; ++a)
#pragma unroll
        for (int b = 0; b < 2; ++b)
#pragma unroll
            for (int m = 0; m < 4; ++m)
#pragma unroll
                for (int n = 0; n < 2; ++n) acc[a][b][m][n] = (f32x4){0.f, 0.f, 0.f, 0.f};
    bf16x8 At[4][2], B0[2][2], B1[2][2];
    const char* cA = (const char*)g.A + (size_t)cur.pm * tstepA; const char* cB = (const char*)g.Bt + (size_t)cur.pn * tstepB;
    S.a_ready(cur);
    if constexpr (SP2) {
        PG8_STAGE(PG8_SB(0, 0), cB, voffB); PG8_STAGE(PG8_SB(0, 1), cB + hstepB, voffB); PG8_STAGE(PG8_SA(0, 0), cA, voffA); PG8_STAGE(PG8_SA(0, 1), cA + hstepA, voffA);
        if (wr == 1) PG8_BAR;
        PG8_WAIT_V(2); PG8_BAR;
        PG8_STAGE(PG8_SB(1, 0), cB + kstep, voffB); PG8_STAGE(PG8_SA(1, 0), cA + kstep, voffA); PG8_STAGE(PG8_SB(1, 1), cB + hstepB + kstep, voffB);
        PG8_WAIT_V(6); PG8_BAR;
    } else {
        PG8_STAGE(PG8_SB(0, 0), cB, voffB); PG8_STAGE(PG8_SA(0, 0), cA, voffA); PG8_STAGE(PG8_SB(0, 1), cB + hstepB, voffB); PG8_STAGE(PG8_SA(0, 1), cA + hstepA, voffA);
        if (wr == 1) PG8_BAR;
        PG8_WAIT_V(4); PG8_BAR;
        PG8_STAGE(PG8_SB(1, 0), cB + kstep, voffB); PG8_STAGE(PG8_SA(1, 0), cA + kstep, voffA); PG8_STAGE(PG8_SB(1, 1), cB + hstepB + kstep, voffB);
        PG8_WAIT_V(6); PG8_BAR;
    }
    for (;;) {
        const bool has_next = S.next(ui + 1, nxt);
        const char* nA = has_next ? (const char*)g.A + (size_t)nxt.pm * tstepA : cA; const char* nB = has_next ? (const char*)g.Bt + (size_t)nxt.pn * tstepB : cB;
        for (int t = 0; t < nt; t += 2) {
            if constexpr (Epi::MIDT > 0) { if (t == Epi::MIDT) E.mid(acc, cur, wr, wc, fr, fq); }
            const bool last = (t == nt - 2);
            const char* a1 = cA + (size_t)(t + 1) * kstep;
            const char* a2 = last ? nA : cA + (size_t)(t + 2) * kstep; const char* b2 = last ? nB : cB + (size_t)(t + 2) * kstep;
            const char* a3 = a2 + kstep; const char* b3 = b2 + kstep;
            if (last && has_next) S.a_ready(nxt);
            if constexpr (SP2) {
            PG8_LDB(B0, 0, 0); PG8_LDB(B1, 0, 1); PG8_SCHED; PG8_LDA(At, 0, 0); PG8_STAGE(PG8_SA(1, 1), a1 + hstepA, voffA);
            PG8_WAIT_V(8); PG8_WAIT_L(0); PG8_BAR; PG8_MMA(0, 0, At, B0); PG8_MMA(0, 1, At, B1); PG8_BAR; PG8_SCHED;
            PG8_LDA(At, 0, 1); PG8_STAGE(PG8_SB(0, 0), b2, voffB); PG8_STAGE(PG8_SB(0, 1), b2 + hstepB, voffB); PG8_STAGE(PG8_SA(0, 0), a2, voffA);
            PG8_WAIT_V(8); PG8_WAIT_L(0); PG8_BAR; PG8_MMA(1, 0, At, B0); PG8_MMA(1, 1, At, B1); PG8_BAR; PG8_SCHED;
            PG8_LDB(B0, 1, 0); PG8_LDB(B1, 1, 1); PG8_SCHED; PG8_LDA(At, 1, 0); PG8_STAGE(PG8_SA(0, 1), a2 + hstepA, voffA);
            PG8_WAIT_V(8); PG8_WAIT_L(0); PG8_BAR; PG8_MMA(0, 0, At, B0); PG8_MMA(0, 1, At, B1); PG8_BAR; PG8_SCHED;
            PG8_LDA(At, 1, 1); PG8_STAGE(PG8_SB(1, 0), b3, voffB); PG8_STAGE(PG8_SB(1, 1), b3 + hstepB, voffB); PG8_STAGE(PG8_SA(1, 0), a3, voffA);
            PG8_WAIT_V(8); PG8_WAIT_L(0); PG8_BAR; PG8_MMA(1, 0, At, B0); PG8_MMA(1, 1, At, B1); PG8_BAR; PG8_SCHED;
            } else {
            PG8_LDB(B0, 0, 0); PG8_SCHED; PG8_LDA(At, 0, 0); PG8_STAGE(PG8_SA(1, 1), a1 + hstepA, voffA);
            PG8_WAIT_L(8); PG8_BAR; PG8_WAIT_L(0); PG8_MMA(0, 0, At, B0); PG8_BAR; PG8_SCHED;
            PG8_LDB(B1, 0, 1); PG8_STAGE(PG8_SB(0, 0), b2, voffB);
            PG8_BAR; PG8_WAIT_L(0); PG8_MMA(0, 1, At, B1); PG8_BAR;
            PG8_LDA(At, 0, 1); PG8_STAGE(PG8_SA(0, 0), a2, voffA);
            PG8_BAR; PG8_WAIT_L(0); PG8_MMA(1, 0, At, B0); PG8_BAR; PG8_SCHED;
            PG8_STAGE(PG8_SB(0, 1), b2 + hstepB, voffB);
            PG8_WAIT_V(6); PG8_BAR; PG8_MMA(1, 1, At, B1); PG8_BAR;
            PG8_LDB(B0, 1, 0); PG8_SCHED; PG8_LDA(At, 1, 0); PG8_STAGE(PG8_SA(0, 1), a2 + hstepA, voffA);
            PG8_WAIT_L(8); PG8_BAR; PG8_WAIT_L(0); PG8_MMA(0, 0, At, B0); PG8_BAR; PG8_SCHED;
            PG8_LDB(B1, 1, 1); PG8_STAGE(PG8_SB(1, 0), b3, voffB);
            PG8_BAR; PG8_WAIT_L(0); PG8_MMA(0, 1, At, B1); PG8_BAR;
            PG8_LDA(At, 1, 1); PG8_STAGE(PG8_SA(1, 0), a3, voffA);
            PG8_BAR; PG8_WAIT_L(0); PG8_MMA(1, 0, At, B0); PG8_BAR; PG8_SCHED;
            PG8_STAGE(PG8_SB(1, 1), b3 + hstepB, voffB);
            PG8_WAIT_V(6); PG8_BAR; PG8_MMA(1, 1, At, B1); PG8_BAR;
            }
        }
        if constexpr (ALIGN_EPI) { if (wr == 0) PG8_BAR; }
        if constexpr (!Epi::AFTER_DRAIN) { E(acc, cur, wr, wc, fr, fq); S.done(cur); }
        if (!has_next) break;
#pragma unroll
        for (int a = 0; a < 2; ++a)
#pragma unroll
            for (int b = 0; b < 2; ++b)
#pragma unroll
                for (int m = 0; m < 4; ++m)
#pragma unroll
                    for (int n = 0; n < 2; ++n) acc[a][b][m][n] = (f32x4){0.f, 0.f, 0.f, 0.f};
        cur = nxt; cA = nA; cB = nB; ++ui;
        if constexpr (ALIGN_EPI) { if (wr == 1) PG8_BAR; }
    }
    PG8_WAIT_V(0);
    if constexpr (!ALIGN_EPI) { if (wr == 0) PG8_BAR; }
    PG8_BAR;
    if constexpr (Epi::AFTER_DRAIN) { E.fused(acc, cur, wr, wc, fr, fq, lds, wid, lane); S.done(cur); }
#undef PG8_SA
#undef PG8_SB
#undef PG8_STAGE
#undef PG8_LDA
#undef PG8_LDB
#undef PG8_MMA
#undef PG8_WAIT_V
#undef PG8_WAIT_L
#undef PG8_BAR
#undef PG8_SCHED
}
}
#include <hip/hip_bf16.h>
#include <cmath>
namespace attn_body {
using bf16=__hip_bfloat16;
using bf16x8=__attribute__((ext_vector_type(8)))short;
using s16x4=__attribute__((ext_vector_type(4)))short;
using f32x16=__attribute__((ext_vector_type(16)))float;
using u32x4=__attribute__((ext_vector_type(4)))unsigned;
constexpr int BATCH=2,SEQ=8192,D=64,QP=768,KVP=256,OP=1024;
constexpr int NW=8,QBLK=32,QB=QBLK*NW,KVBLK=64,NQB=SEQ/QB;
constexpr int ATTN_UNIT_ROWS=QB;
__device__ __forceinline__ int crow(int r,int hi){return (r&3)+8*(r>>2)+4*hi;}
#define SBAR() __builtin_amdgcn_sched_barrier(0)
__device__ __forceinline__ void cmask(f32x16&p0,f32x16&p1,int jb,int qrel,int hi){
  const float NEG=-INFINITY; int kb=64*jb+4*hi;
  #pragma unroll
  for(int r=0;r<16;++r){int kv=kb+(r&3)+8*(r>>2); if(kv>qrel)p0[r]=NEG; if(kv+32>qrel)p1[r]=NEG;}
}

constexpr int NSLOT=3, SLOTB=8192;
constexpr int LDS_K=0, LDS_V=NSLOT*SLOTB, LDS_WS=2*NSLOT*SLOTB, LDS_OST=LDS_WS+NW*64*4, LDS_BYTES=LDS_OST+NW*4096;
constexpr float C2=0.125f*1.4426950408889634f;
__device__ __forceinline__ void glds16(const void*gsrc,unsigned lds_dst){unsigned keep;
  asm volatile("s_mov_b32 %0, m0\n\ts_mov_b32 m0, %2\n\ts_nop 0\n\tglobal_load_lds_dwordx4 %1, off\n\ts_mov_b32 m0, %0":"=&s"(keep):"v"(gsrc),"s"(lds_dst):"memory");}
__device__ __forceinline__ float max3f(float a,float b,float c){float r;asm("v_max3_f32 %0, %1, %2, %3":"=v"(r):"v"(a),"v"(b),"v"(c));return r;}
__device__ __forceinline__ float max2f(float a,float b){float r;asm("v_max_f32_e32 %0, %1, %2":"=v"(r):"v"(a),"v"(b));return r;}
__device__ __forceinline__ float fadd_s(float a,float b){float r;asm("v_add_f32_e32 %0, %1, %2":"=v"(r):"v"(a),"v"(b));return r;}
__device__ __forceinline__ float fsub_s(float a,float b){float r;asm("v_sub_f32_e32 %0, %1, %2":"=v"(r):"v"(a),"v"(b));return r;}
typedef float f32x2_t __attribute__((ext_vector_type(2))); typedef __bf16 bf16x2_t __attribute__((ext_vector_type(2)));
__device__ __forceinline__ unsigned cvtpk_s(float lo,float hi){f32x2_t v={lo,hi};bf16x2_t b=__builtin_convertvector(v,bf16x2_t);return __builtin_bit_cast(unsigned,b);}
#define WAIT_BAR(N) asm volatile("s_waitcnt vmcnt(" #N ") lgkmcnt(0)\n\ts_barrier":::"memory")

__device__ __forceinline__ void qkt(f32x16&p0,f32x16&p1,const char*Kslot,const bf16x8*qr,const f32x16&negm,int r32,int hi){
  const char*kb=Kslot+hi*1024+r32*16;
  #pragma unroll
  for(int d0=0;d0<4;++d0){
    const bf16x8 b0=*reinterpret_cast<const bf16x8*>(kb+d0*2048);
    const bf16x8 b1=*reinterpret_cast<const bf16x8*>(kb+d0*2048+512);
    if(d0==0){p0=__builtin_amdgcn_mfma_f32_32x32x16_bf16(b0,qr[0],negm,0,0,0);p1=__builtin_amdgcn_mfma_f32_32x32x16_bf16(b1,qr[0],negm,0,0,0);}
    else{p0=__builtin_amdgcn_mfma_f32_32x32x16_bf16(b0,qr[d0],p0,0,0,0);p1=__builtin_amdgcn_mfma_f32_32x32x16_bf16(b1,qr[d0],p1,0,0,0);}}
}
typedef __attribute__((address_space(3))) const char* lds_cptr;
typedef short v4i16_t __attribute__((ext_vector_type(4)));
__device__ __forceinline__ void kload8(bf16x8*kf,lds_cptr kp){
  kf[0]=*(const __attribute__((address_space(3))) bf16x8*)(kp);      kf[1]=*(const __attribute__((address_space(3))) bf16x8*)(kp+512);
  kf[2]=*(const __attribute__((address_space(3))) bf16x8*)(kp+2048); kf[3]=*(const __attribute__((address_space(3))) bf16x8*)(kp+2560);
  kf[4]=*(const __attribute__((address_space(3))) bf16x8*)(kp+4096); kf[5]=*(const __attribute__((address_space(3))) bf16x8*)(kp+4608);
  kf[6]=*(const __attribute__((address_space(3))) bf16x8*)(kp+6144); kf[7]=*(const __attribute__((address_space(3))) bf16x8*)(kp+6656);
}
__device__ __forceinline__ void kload2(bf16x8*kf,lds_cptr kp,int j){ kf[2*j]=*(const __attribute__((address_space(3))) bf16x8*)(kp+j*2048); kf[2*j+1]=*(const __attribute__((address_space(3))) bf16x8*)(kp+j*2048+512); }
__device__ __forceinline__ s16x4 vtr(lds_cptr p){ return __builtin_bit_cast(s16x4,__builtin_amdgcn_ds_read_tr16_b64_v4i16((__attribute__((address_space(3))) v4i16_t*)p)); }
__device__ __forceinline__ float rowmax(const f32x16&p0,const f32x16&p1){
  float a=max3f(p0[0],p0[1],p1[0]),b=max3f(p0[2],p0[3],p1[1]);a=max3f(a,p1[2],p1[3]);
  #pragma unroll
  for(int r=4;r<16;r+=4){a=max3f(a,p0[r],p0[r+1]);b=max3f(b,p0[r+2],p0[r+3]);a=max3f(a,p1[r],p1[r+1]);b=max3f(b,p1[r+2],p1[r+3]);}
  const float m=max2f(a,b);
  auto rr=__builtin_amdgcn_permlane32_swap(__float_as_uint(m),__float_as_uint(m),false,false);
  return max2f(__uint_as_float(rr[0]),__uint_as_float(rr[1]));
}
__device__ __forceinline__ void pv(f32x16*o,int vb,bf16x8 pa0,bf16x8 pa1,bf16x8 pa2,bf16x8 pa3){
  #pragma unroll
  for(int d0=0;d0<2;++d0){s16x4 lo[4],hi[4];
    #pragma unroll
    for(int ks=0;ks<4;++ks){
      asm volatile("ds_read_b64_tr_b16 %0,%1 offset:%c2":"=&v"(lo[ks]):"v"(vb),"i"(d0*4096+ks*1024):"memory");
      asm volatile("ds_read_b64_tr_b16 %0,%1 offset:%c2":"=&v"(hi[ks]):"v"(vb),"i"(d0*4096+ks*1024+512):"memory");}
    asm volatile("s_waitcnt lgkmcnt(0)":::"memory");SBAR();
    #define PK(k) (bf16x8){lo[k][0],lo[k][1],lo[k][2],lo[k][3],hi[k][0],hi[k][1],hi[k][2],hi[k][3]}
    o[d0]=__builtin_amdgcn_mfma_f32_32x32x16_bf16(pa0,PK(0),o[d0],0,0,0);
    o[d0]=__builtin_amdgcn_mfma_f32_32x32x16_bf16(pa1,PK(1),o[d0],0,0,0);
    o[d0]=__builtin_amdgcn_mfma_f32_32x32x16_bf16(pa2,PK(2),o[d0],0,0,0);
    o[d0]=__builtin_amdgcn_mfma_f32_32x32x16_bf16(pa3,PK(3),o[d0],0,0,0);
    #undef PK
  }
}

#ifndef ATTN_STORE16
#define ATTN_STORE16(p,v) (*(u32x4*)(p)=(v))
#endif
template<int THRL> __device__ __forceinline__ void attn_unit(int b,int h,int kvh,int qb,const bf16*Q,const bf16*__restrict__ K,const bf16*__restrict__ V,bf16*O,char*shm){
  int tid_o=threadIdx.x; asm volatile("":"+v"(tid_o)); const int tid=tid_o,lane=tid&63,r32=lane&31,hi=lane>>5; const int wid=__builtin_amdgcn_readfirstlane(tid>>6);
  const long rowbase=(long)b*SEQ; const int q0=qb*QB;
  const bf16*Qw=Q+(rowbase+q0+wid*QBLK)*QP+h*D;
  const bf16*Kh=K+rowbase*KVP+kvh*D,*Vh=V+rowbase*KVP+kvh*D;
  const unsigned lds0=(unsigned)(uintptr_t)shm;
  float*wsf=(float*)(shm+LDS_WS)+wid*64;
  const bf16*ksrc=Kh+(long)lane*KVP+wid*8;
  const bf16*vsrc=Vh+(long)(16*(wid&3)+(lane>>2))*KVP+(wid>>2)*32+(lane&3)*8;
  const unsigned kdst=lds0+LDS_K+wid*1024, vdst=lds0+LDS_V+wid*1024;
  #define DMA_K(t,slot) glds16(ksrc+(long)(t)*KVBLK*KVP,(unsigned)__builtin_amdgcn_readfirstlane(kdst+(slot)))
  #define DMA_V(t,slot) glds16(vsrc+(long)(t)*KVBLK*KVP,(unsigned)__builtin_amdgcn_readfirstlane(vdst+(slot)))
  const int vb0=(int)(lds0+LDS_V)+((lane>>4)&1)*32+(lane&3)*8+(4*hi+((lane&15)>>2))*64;
  const char*Kbase=shm+LDS_K; bf16x8 kf[8];
  const lds_cptr shm3=(lds_cptr)shm; const lds_cptr kp0=shm3+LDS_K+hi*1024+r32*16; const lds_cptr vp0=shm3+LDS_V+((lane>>4)&1)*32+(lane&3)*8+(4*hi+((lane&15)>>2))*64;
  const int NT=SEQ/KVBLK;
  DMA_K(0,0);DMA_V(0,0);DMA_K(1,SLOTB);
  bf16x8 qr[4];
  #pragma unroll
  for(int d0=0;d0<4;++d0)qr[d0]=*reinterpret_cast<const bf16x8*>(&Qw[(long)r32*QP+d0*16+hi*8]);
  float mhat=0.f,l_reg=0.f;f32x16 o[2];o[0]=f32x16{};o[1]=f32x16{};f32x16 negm=f32x16{};asm volatile("":"+v"(negm));
  #define CMASK(P0,P1,t) do{}while(0)
  bool resc=false;
  #define START(P0,P1) do{ const float rm=rowmax(P0,P1); resc=false; \
    { const float dl=rm; mhat=fadd_s(mhat,dl); \
      _Pragma("unroll") for(int r=0;r<16;++r){P0[r]=fsub_s(P0[r],dl);P1[r]=fsub_s(P1[r],dl);} \
      _Pragma("unroll") for(int r=0;r<16;++r)negm[r]=-mhat; asm volatile("":"+v"(negm)); } \
    _Pragma("unroll") for(int r=0;r<16;++r)P0[r]=__builtin_amdgcn_exp2f(P0[r]); }while(0)
  #define RESC() do{ if(resc){ asm volatile("s_waitcnt lgkmcnt(0)":::"memory"); \
      _Pragma("unroll") for(int d_=0;d_<2;++d_) _Pragma("unroll") for(int r=0;r<16;++r)o[d_][r]*=wsf[crow(r,hi)]; } }while(0)
  f32x16 pA0,pA1,pB0,pB1;
  int sl_prev=0,sl_cur=0,sl_next=SLOTB;
  #define ROT() do{sl_prev=sl_cur;sl_cur=sl_next;sl_next=(sl_next==(NSLOT-1)*SLOTB)?0:sl_next+SLOTB;}while(0)
  DMA_K(2,2*SLOTB);
  WAIT_BAR(3);
  qkt(pA0,pA1,Kbase,qr,negm,r32,hi);asm volatile("s_nop 15\n\ts_nop 7":"+v"(pA0),"+v"(pA1));CMASK(pA0,pA1,0);
  START(pA0,pA1);
  _Pragma("unroll") for(int r=0;r<16;++r)pA1[r]=__builtin_amdgcn_exp2f(pA1[r]);
  WAIT_BAR(0);
  DMA_K(3,0);DMA_V(1,SLOTB);
  ROT();
  kload8(kf,kp0+sl_cur);
  WAIT_BAR(2);
  s16x4 vlo[8],vhi[8]; u32x4 pw0,pw1,pw2,pw3;
  #define PKW(P,B) cvtpk_s(P[B],P[B+1])
  #define PAF(k) __builtin_bit_cast(bf16x8,pw##k)
  #define VFR(i) (bf16x8){vlo[i][0],vlo[i][1],vlo[i][2],vlo[i][3],vhi[i][0],vhi[i][1],vhi[i][2],vhi[i][3]}
  #define PIN(x) asm volatile("":"+v"(x))
  #define MX3(a,b,c) __builtin_fmaxf(__builtin_fmaxf((a),(b)),(c))
  #define GAPA(MF,A0,A1,A2,A3,W0,W1,PW) do{ MF; sacc+=A0; sacc+=A1; sacc+=A2; sacc+=A3; PIN(sacc); W0; W1; PIN(PW); SBAR(); }while(0)
  #define EX(v) __builtin_amdgcn_exp2f(v)
  #define GAPB(MF,X,B) do{ MF; X[B]=EX(X[B]); X[B+1]=EX(X[B+1]); X[B+2]=EX(X[B+2]); X[B+3]=EX(X[B+3]); PIN(X); SBAR(); }while(0)
  #define VRD(i) do{ vlo[i]=vtr(vp_+(((i)>>2)*4096+((i)&3)*1024)); vhi[i]=vtr(vp_+(((i)>>2)*4096+((i)&3)*1024+512)); }while(0)
  #define KRD(G,j) do{ if(G){ kload2(kf,kp0+sl_next,j); SBAR(); } }while(0)
  #define STEP(C0,C1,P0,P1,t,GK,GV,GL) do{ SBAR(); \
    const lds_cptr vp_=vp0+sl_prev; \
    VRD(0); SBAR(); float sacc=(P0[0]+P0[1]); \
    GAPA(C0=__builtin_amdgcn_mfma_f32_32x32x16_bf16(kf[0],qr[0],negm,0,0,0), P0[2],P0[3],P0[4],P0[5],     pw0[0]=PKW(P0,0), pw0[1]=PKW(P0,2), pw0); \
    VRD(4); SBAR(); GAPA(C1=__builtin_amdgcn_mfma_f32_32x32x16_bf16(kf[1],qr[0],negm,0,0,0), P0[6],P0[7],P0[8],P0[9],     pw0[2]=PKW(P0,4), pw0[3]=PKW(P0,6), pw0); \
    VRD(1); SBAR(); GAPA(C0=__builtin_amdgcn_mfma_f32_32x32x16_bf16(kf[2],qr[1],C0,0,0,0),   P0[10],P0[11],P0[12],P0[13], pw1[0]=PKW(P0,8), pw1[1]=PKW(P0,10), pw1); \
    VRD(5); SBAR(); GAPA(C1=__builtin_amdgcn_mfma_f32_32x32x16_bf16(kf[3],qr[1],C1,0,0,0),   P0[14],P0[15],P1[0],P1[1],   pw1[2]=PKW(P0,12),pw1[3]=PKW(P0,14), pw1); \
    VRD(2); SBAR(); GAPA(C0=__builtin_amdgcn_mfma_f32_32x32x16_bf16(kf[4],qr[2],C0,0,0,0),   P1[2],P1[3],P1[4],P1[5],     pw2[0]=PKW(P1,0), pw2[1]=PKW(P1,2), pw2); \
    VRD(6); SBAR(); GAPA(C1=__builtin_amdgcn_mfma_f32_32x32x16_bf16(kf[5],qr[2],C1,0,0,0),   P1[6],P1[7],P1[8],P1[9],     pw2[2]=PKW(P1,4), pw2[3]=PKW(P1,6), pw2); \
    VRD(3); SBAR(); GAPA(C0=__builtin_amdgcn_mfma_f32_32x32x16_bf16(kf[6],qr[3],C0,0,0,0),   P1[10],P1[11],P1[12],P1[13], pw3[0]=PKW(P1,8), pw3[1]=PKW(P1,10), pw3); \
    VRD(7); SBAR(); GAPA(C1=__builtin_amdgcn_mfma_f32_32x32x16_bf16(kf[7],qr[3],C1,0,0,0),   P1[14],P1[15],0.f,0.f,       pw3[2]=PKW(P1,12),pw3[3]=PKW(P1,14), pw3); \
    l_reg+=sacc; \
    if(GK){DMA_K((t)+3,sl_cur);} if(GV){DMA_V((t)+1,sl_next);} \
    CMASK(C0,C1,t); \
    { float a=MX3(C0[0],C0[1],C1[0]),b=MX3(C0[2],C0[3],C1[1]); a=MX3(a,C1[2],C1[3]); \
      _Pragma("unroll") for(int r=4;r<16;r+=4){a=MX3(a,C0[r],C0[r+1]);b=MX3(b,C0[r+2],C0[r+3]);a=MX3(a,C1[r],C1[r+1]);b=MX3(b,C1[r+2],C1[r+3]);} \
      float rm=__builtin_fmaxf(a,b); { auto rr=__builtin_amdgcn_permlane32_swap(__float_as_uint(rm),__float_as_uint(rm),false,false); rm=__builtin_fmaxf(__uint_as_float(rr[0]),__uint_as_float(rr[1])); } \
      resc=false; \
      if(__builtin_expect(__any(rm>(float)THRL),0)){ const float dl=__builtin_fmaxf(rm,0.f); mhat+=dl; \
        _Pragma("unroll") for(int r=0;r<16;++r){C0[r]-=dl;C1[r]-=dl;} \
        _Pragma("unroll") for(int r=0;r<16;++r)negm[r]=-mhat; asm volatile("":"+v"(negm)); \
        const float f=__builtin_amdgcn_exp2f(-dl); l_reg*=f; if(hi==0)wsf[r32]=f; resc=true; } } \
    SBAR(); \
    GAPB(o[0]=__builtin_amdgcn_mfma_f32_32x32x16_bf16(PAF(0),VFR(0),o[0],0,0,0), C0,0); \
    GAPB(o[1]=__builtin_amdgcn_mfma_f32_32x32x16_bf16(PAF(0),VFR(4),o[1],0,0,0), C0,4); \
    KRD(GL,0); GAPB(o[0]=__builtin_amdgcn_mfma_f32_32x32x16_bf16(PAF(1),VFR(1),o[0],0,0,0), C0,8); \
    KRD(GL,1); GAPB(o[1]=__builtin_amdgcn_mfma_f32_32x32x16_bf16(PAF(1),VFR(5),o[1],0,0,0), C0,12); \
    KRD(GL,2); GAPB(o[0]=__builtin_amdgcn_mfma_f32_32x32x16_bf16(PAF(2),VFR(2),o[0],0,0,0), C1,0); \
    KRD(GL,3); GAPB(o[1]=__builtin_amdgcn_mfma_f32_32x32x16_bf16(PAF(2),VFR(6),o[1],0,0,0), C1,4); \
    GAPB(o[0]=__builtin_amdgcn_mfma_f32_32x32x16_bf16(PAF(3),VFR(3),o[0],0,0,0), C1,8); \
    GAPB(o[1]=__builtin_amdgcn_mfma_f32_32x32x16_bf16(PAF(3),VFR(7),o[1],0,0,0), C1,12); \
    }while(0)
  int t=1;
  #undef CMASK
  #define CMASK(P0,P1,t) do{}while(0)
  for(;t+5<NT;t+=2){
    STEP(pB0,pB1,pA0,pA1,t,true,true,true);     WAIT_BAR(2); RESC(); ROT();
    STEP(pA0,pA1,pB0,pB1,t+1,true,true,true);   WAIT_BAR(2); RESC(); ROT();
  }
  #undef CMASK
  #define CMASK(P0,P1,t) do{}while(0)
  #define ENDW(tt) do{ if((tt)+3<NT){WAIT_BAR(2);} else if((tt)+2<NT){WAIT_BAR(1);} else {WAIT_BAR(0);} }while(0)
  for(;t+1<NT;t+=2){
    STEP(pB0,pB1,pA0,pA1,t,(t+3<NT),(t+1<NT),(t+1<NT));       ENDW(t);   RESC(); ROT();
    STEP(pA0,pA1,pB0,pB1,t+1,(t+4<NT),(t+2<NT),(t+2<NT));     ENDW(t+1); RESC(); ROT();
  }
  STEP(pB0,pB1,pA0,pA1,NT-1,false,false,false); RESC();
  { float sacc=pB0[0]+pB0[1]; _Pragma("unroll") for(int r=2;r<16;++r)sacc+=pB0[r]; _Pragma("unroll") for(int r=0;r<16;++r)sacc+=pB1[r]; l_reg+=sacc;
    pw0=(u32x4){PKW(pB0,0),PKW(pB0,2),PKW(pB0,4),PKW(pB0,6)};pw1=(u32x4){PKW(pB0,8),PKW(pB0,10),PKW(pB0,12),PKW(pB0,14)};pw2=(u32x4){PKW(pB1,0),PKW(pB1,2),PKW(pB1,4),PKW(pB1,6)};pw3=(u32x4){PKW(pB1,8),PKW(pB1,10),PKW(pB1,12),PKW(pB1,14)};
    SBAR(); pv(o,vb0+sl_cur,PAF(0),PAF(1),PAF(2),PAF(3)); }
  #undef PKW
  #undef PAF
  #undef VFR
  #undef PIN
  #undef MX3
  #undef GAPA
  #undef GAPB
  #undef EX
  #undef VRD
  #undef KRD
  #undef STEP
  #undef ENDW
  {auto rr=__builtin_amdgcn_permlane32_swap(__float_as_uint(l_reg),__float_as_uint(l_reg),false,false);l_reg=__uint_as_float(rr[0])+__uint_as_float(rr[1]);}
  if(hi==0)wsf[32+r32]=l_reg;asm volatile("s_waitcnt lgkmcnt(0)":::"memory");
  float rli[16];
  #pragma unroll
  for(int r=0;r<16;++r)rli[r]=__builtin_amdgcn_rcpf(wsf[32+crow(r,hi)]);
  bf16*Ow=O+(rowbase+q0+wid*QBLK)*OP+h*D;
  { bf16*stg=(bf16*)(shm+LDS_OST)+wid*2048;
    #pragma unroll
    for(int r=0;r<16;++r){const int orow=crow(r,hi);
      #pragma unroll
      for(int d0=0;d0<2;++d0)stg[orow*64+d0*32+r32]=__float2bfloat16(o[d0][r]*rli[r]);}
    asm volatile("s_waitcnt lgkmcnt(0)":::"memory");
    #pragma unroll
    for(int i=0;i<4;++i){const int row=i*8+(lane>>3),ch=lane&7; const u32x4 v=*(const u32x4*)(stg+row*64+ch*8); ATTN_STORE16(Ow+(long)row*OP+ch*8,v);} }
  asm volatile("s_waitcnt lgkmcnt(0)\n\ts_barrier":::"memory");
  #undef DMA_K
  #undef DMA_V
  #undef CMASK
  #undef START
  #undef RESC
  #undef ROT
}
constexpr int ATTN_LDS_BYTES=LDS_BYTES;
struct AttnTensors { const bf16* Q; const bf16* K; const bf16* V; bf16* O; };
template<int THRL=8> __device__ __forceinline__ void attn_phase(char*lds,const AttnTensors&T,int vcu,int G){
  for(int u=vcu;u<768;u+=G){ const int j=u&31,grp=(u>>5)&7,i=u>>8; const int b=grp>>2,kvh=grp&3,h=kvh*3+i;
    attn_unit<THRL>(b,h,kvh,j,T.Q,T.K,T.V,T.O,lds); }
}
#undef SBAR
#undef WAIT_BAR
}
constexpr int NWAVES = 8;
#ifndef MK_PER_PHASE
#define MK_PER_PHASE 0
#endif
constexpr int BATCH = 2, T = 8192, D = 1024, FF = 4096, DEPTH = 4, INW = 3584;
constexpr int M = BATCH * T;
constexpr int N_PHASES = 2 + 7 * DEPTH;
constexpr size_t MiB = 1u << 20;
constexpr size_t WS_SS = 1 * MiB;
constexpr size_t WS_W = 2 * MiB, W_LAYER_ELEMS = (size_t)27 * MiB / 2;
constexpr size_t WO_IN = 0, WO_AB = (size_t)INW * D, WO_OUT = WO_AB + (size_t)D * D, WO_UP = WO_OUT + (size_t)D * D, WO_DOWN = WO_UP + (size_t)FF * D;
static_assert(WO_DOWN + (size_t)D * FF == W_LAYER_ELEMS, "weight buffer");
constexpr size_t WS_XB = 56 * MiB;
constexpr size_t WS_Q = 88 * MiB, WS_K = 112 * MiB, WS_V = 120 * MiB, WS_F = 128 * MiB, WS_G = 136 * MiB, WS_AO = 200 * MiB, WS_YP = 232 * MiB, WS_END = 248 * MiB;
constexpr size_t WS_MG = WS_Q;
constexpr size_t WS_H = WS_Q;
static_assert(WS_H + (size_t)M * FF * 2 <= WS_YP, "h overlay");
constexpr int RING_BYTES = 131072, LDS_BYTES = 147456;
#define GAS __attribute__((address_space(1)))
#define LAS __attribute__((address_space(3)))
typedef unsigned short bf16;
typedef unsigned v4u __attribute__((ext_vector_type(4)));
typedef unsigned v2u __attribute__((ext_vector_type(2)));
typedef float f32x4 __attribute__((ext_vector_type(4)));
typedef short bf16x8 __attribute__((ext_vector_type(8)));
#define LDS_WAIT() asm volatile("s_waitcnt lgkmcnt(0)" ::: "memory")
__device__ __forceinline__ unsigned f2bf(float f) { unsigned u = __builtin_bit_cast(unsigned, f); return (u + 0x7fffu + ((u >> 16) & 1u)) >> 16; }
__device__ __forceinline__ unsigned pk2(float lo, float hi) { return f2bf(lo) | (f2bf(hi) << 16); }
__device__ __forceinline__ float wave_sum(float v) {
#pragma unroll
    for (int o = 1; o < 64; o <<= 1) v += __shfl_xor(v, o);
    return v;
}
__device__ __forceinline__ void transpose_item(const float* W, int ldw, const float* gain, bf16* WT, int ldt, int k0, int n0, int v0, int kcol0, LAS float* scr, int lane) {
    float wv[32];
#pragma unroll
    for (int i = 0; i < 32; ++i) wv[i] = W[(size_t)(k0 + 2 * i + (lane >> 5)) * ldw + n0 + (lane & 31)];
    if (gain) {
#pragma unroll
        for (int i = 0; i < 32; ++i) wv[i] *= gain[k0 + 2 * i + (lane >> 5)];
    }
#pragma unroll
    for (int i = 0; i < 32; ++i) scr[(2 * i + (lane >> 5)) * 33 + (lane & 31)] = wv[i];
    LDS_WAIT(); asm volatile("" ::: "memory");
    const int c = lane & 7;
#pragma unroll
    for (int j = 0; j < 4; ++j) { const int n = (lane >> 3) + 8 * j; const LAS float* s = scr + (8 * c) * 33 + n;
        v4u o; o.x = pk2(s[0 * 33], s[1 * 33]); o.y = pk2(s[2 * 33], s[3 * 33]); o.z = pk2(s[4 * 33], s[5 * 33]); o.w = pk2(s[6 * 33], s[7 * 33]);
        *(GAS v4u*)(WT + (size_t)(v0 + n) * ldt + kcol0 + k0 + 8 * c) = o; }
    LDS_WAIT(); asm volatile("" ::: "memory");
}
#define RLX_AGENT __ATOMIC_RELAXED, __HIP_MEMORY_SCOPE_AGENT

#define XB_TMO      128
#define XB_XCNT(j)  (256  + 64 * (j))
#define XB_XSUB(j)  (1280 + 64 * (j))
#define XB_XGEN(j)  (2304 + 64 * (j))
#define XB_TOP      3328
#define XB_TOPGEN   3392
#define XCD_BAR_WORDS 3456
#define XB_SPIN_CAP (1u << 18)

__device__ __forceinline__ unsigned xb_ld(unsigned* p)              { return __hip_atomic_load(p, __ATOMIC_RELAXED, __HIP_MEMORY_SCOPE_AGENT); }
__device__ __forceinline__ unsigned xb_add(unsigned* p, unsigned v) { return __hip_atomic_fetch_add(p, v, __ATOMIC_RELAXED, __HIP_MEMORY_SCOPE_AGENT); }
__device__ __forceinline__ unsigned xb_xcc_id() { return (unsigned)__builtin_amdgcn_s_getreg((3 << 11) | 20) & 0xFu; }
#define XB_SPIN(cond, bar) do { unsigned _sp = 0; while (cond) { __builtin_amdgcn_s_sleep(1); \
    if ((++_sp & 255u) == 0u) { if (xb_ld(&(bar)[XB_TMO])) break; if (_sp > XB_SPIN_CAP) { atomicAdd(&(bar)[XB_TMO], 1u); break; } } } } while (0)

struct XcdBarrier {
    unsigned* bar; unsigned x;
    volatile LAS unsigned* st;
};

__device__ __forceinline__ XcdBarrier xcd_barrier_post(unsigned* bar, volatile LAS unsigned* st) {
    XcdBarrier b; b.bar = bar; b.x = xb_xcc_id(); b.st = st;
    if (threadIdx.x == 0) (void)xb_add(&bar[XB_XCNT(b.x)], 1u);
    return b;
}
__device__ __forceinline__ void xcd_barrier_complete(unsigned* bar, unsigned x, unsigned& nloc, unsigned& nx) {
    const unsigned G = gridDim.x * gridDim.y * gridDim.z;
    unsigned sum, cnt, mine, sp = 0u;
    for (;;) {
        sum = 0u; cnt = 0u; mine = 0u;
#pragma unroll
        for (unsigned j = 0; j < 16; ++j) { const unsigned c = xb_ld(&bar[XB_XCNT(j)]); sum += c; cnt += (c > 0u) ? 1u : 0u; mine = (j == x) ? c : mine; }
        if (sum == G) break;
        __builtin_amdgcn_s_sleep(1);
        if ((++sp & 255u) == 0u) { if (xb_ld(&bar[XB_TMO])) break; if (sp > XB_SPIN_CAP) { atomicAdd(&bar[XB_TMO], 1u); break; } }
    }
    nloc = mine > 0u ? mine : 1u; nx = cnt > 0u ? cnt : 1u;
}

__device__ __forceinline__ void xcd_barrier(const XcdBarrier& b) {
    asm volatile("s_waitcnt vmcnt(0)" ::: "memory");
    __syncthreads();
    if (threadIdx.x == 0) {
        unsigned* bar = b.bar;
        __builtin_amdgcn_s_waitcnt(0);
        unsigned nloc = b.st[0], nx = b.st[1];
        if (nloc == 0u) { xcd_barrier_complete(bar, b.x, nloc, nx); b.st[0] = nloc; b.st[1] = nx; }
        const unsigned old = xb_add(&bar[XB_XSUB(b.x)], 1u);
        const unsigned gen = old / nloc;
        if (old + 1u == (gen + 1u) * nloc) {
            __builtin_amdgcn_fence(__ATOMIC_RELEASE, "agent");
            asm volatile("s_waitcnt vmcnt(0)" ::: "memory");
            const unsigned og = xb_add(&bar[XB_TOP], 1u);
            const unsigned tg = og / nx;
            if (og + 1u == (tg + 1u) * nx) xb_add(&bar[XB_TOPGEN], 1u);
            else XB_SPIN(xb_ld(&bar[XB_TOPGEN]) == tg, bar);
            __builtin_amdgcn_fence(__ATOMIC_ACQUIRE, "agent");
            xb_add(&bar[XB_XGEN(b.x)], 1u);
            asm volatile("s_waitcnt vmcnt(0)" ::: "memory");
        } else {
            XB_SPIN(xb_ld(&bar[XB_XGEN(b.x)]) == gen, bar);
            __builtin_amdgcn_fence(__ATOMIC_ACQUIRE, "agent");
            asm volatile("s_waitcnt vmcnt(0)" ::: "memory");
        }
    }
    __syncthreads();
}
constexpr int RSTD_OFF = RING_BYTES + 1024;
constexpr int MISC_OFF = RING_BYTES + 320;
constexpr size_t WS_GCNT = 131072;
constexpr size_t WS_CNT = 65536;
constexpr size_t WS_BAR = 16384;
constexpr size_t WS_XTAB = 163840;
__device__ __forceinline__ void group_barrier(unsigned* cnt, const unsigned* xtab, volatile LAS unsigned* same_xcc) {
    asm volatile("s_waitcnt vmcnt(0)" ::: "memory");
    __syncthreads();
    if (threadIdx.x == 0) {
        unsigned sx = *same_xcc;
        if (sx == 0u) { const unsigned g = blockIdx.x & 63u; const unsigned a = xb_ld((unsigned*)xtab + g), b = xb_ld((unsigned*)xtab + g + 64), c = xb_ld((unsigned*)xtab + g + 128), d = xb_ld((unsigned*)xtab + g + 192);
            sx = (a != 0u && a == b && b == c && c == d) ? 1u : 2u; *same_xcc = sx; }
        if (sx != 1u) { __builtin_amdgcn_fence(__ATOMIC_RELEASE, "agent"); asm volatile("s_waitcnt vmcnt(0)" ::: "memory"); }
        const unsigned old = xb_add(cnt, 1u), target = (old / 4u + 1u) * 4u; unsigned sp = 0;
        while (xb_ld(cnt) < target) { __builtin_amdgcn_s_sleep(1); if (++sp > (1u << 24)) break; }
        __builtin_amdgcn_fence(__ATOMIC_ACQUIRE, "agent"); asm volatile("s_waitcnt vmcnt(0)" ::: "memory");
    }
    __syncthreads();
}
struct Args { const float* in[13]; float* out; unsigned char* ws; int ph_lo, ph_hi; };
__device__ __forceinline__ void convert_layer(const __attribute__((address_space(4))) Args* a, int L, bf16* wbuf, LAS float* scr, int gw, int NGW, int lane, int part) {
    asm volatile("" : "+v"(lane));
    constexpr int I_IN = 16 * 112, I_A = 12 * 32, I_F = 4 * 32, I_O = 16 * 32, I_UP = 16 * 128, I_DN = 64 * 32, NITEMS = I_IN + I_A + I_F + I_O + I_UP + I_DN;
    const int it_lo = (part == 2) ? I_IN : 0, it_hi = (part == 1) ? I_IN : NITEMS;
    for (int it = it_lo + gw; it < it_hi; it += NGW) {
        int r = it;
        if (r < I_IN) { const int kb = r / 112, n0 = 32 * (r % 112); const int v0 = (n0 < 1024) ? (n0 & ~255) + 128 * ((n0 >> 5) & 1) + 32 * ((n0 >> 6) & 3) : n0;
            transpose_item(a->in[2] + (size_t)L * D * INW, INW, a->in[1] + L * D, wbuf + WO_IN, D, 64 * kb, n0, v0, 0, scr, lane); continue; } r -= I_IN;
        if (r < I_A) { transpose_item(a->in[6] + (size_t)L * 768 * D, D, nullptr, wbuf + WO_AB, D, 64 * (r / 32), 32 * (r % 32), 32 * (r % 32), 0, scr, lane); continue; } r -= I_A;
        if (r < I_F) { transpose_item(a->in[7] + (size_t)L * 256 * D, D, nullptr, wbuf + WO_AB, D, 64 * (r / 32), 32 * (r % 32), 32 * (r % 32), 768, scr, lane); continue; } r -= I_F;
        if (r < I_O) { transpose_item(a->in[8] + (size_t)L * D * D, D, nullptr, wbuf + WO_OUT, D, 64 * (r / 32), 32 * (r % 32), 32 * (r % 32), 0, scr, lane); continue; } r -= I_O;
        if (r < I_UP) { transpose_item(a->in[10] + (size_t)L * D * FF, FF, a->in[9] + L * D, wbuf + WO_UP, D, 64 * (r / 128), 32 * (r % 128), 32 * (r % 128), 0, scr, lane); continue; } r -= I_UP;
        transpose_item(a->in[11] + (size_t)L * FF * D, D, nullptr, wbuf + WO_DOWN, FF, 64 * (r / 32), 32 * (r % 32), 32 * (r % 32), 0, scr, lane);
    }
}
__device__ __forceinline__ unsigned short f2bf16(float f) { return (unsigned short)f2bf(f); }
#define MFMA16(a, b, c) __builtin_amdgcn_mfma_f32_16x16x32_bf16((a), (b), (c), 0, 0, 0)
__device__ __forceinline__ void fourier_a_phase(LAS unsigned char* lds, const bf16* Fb, bf16* Yp, int vcu, int G, int tid) {
    asm volatile("" : "+v"(tid));
    const int lane = tid & 63, w = __builtin_amdgcn_readfirstlane(tid >> 6), fr = lane & 15, fq = lane >> 4;
    constexpr int XS = 144, TS = 272, T_OFF = 128 * XS;
    bf16x8 w1[2], cb[4], sb[4];
    { const int n = 16 * w + fr, cp = n & 63; const bool isS = n >= 64;
#pragma unroll
      for (int ks = 0; ks < 2; ++ks)
#pragma unroll
        for (int e = 0; e < 8; ++e) { const int c = 32 * ks + 8 * fq + e; const float ph = (float)((cp * c) & 63) * (1.0f / 64.0f);
            w1[ks][e] = (short)f2bf16((isS ? __builtin_amdgcn_sinf(ph) : __builtin_amdgcn_cosf(ph)) * 0.125f); } }
    const int k1 = 16 * w + fr;
#pragma unroll
    for (int ks = 0; ks < 4; ++ks)
#pragma unroll
        for (int e = 0; e < 8; ++e) { const int r = 32 * ks + 8 * fq + e; const float ph = (float)((k1 * r) & 127) * (1.0f / 128.0f);
            cb[ks][e] = (short)f2bf16(__builtin_amdgcn_cosf(ph) * 0.08838834764831845f); sb[ks][e] = (short)f2bf16(__builtin_amdgcn_sinf(ph) * 0.08838834764831845f); }
    v4u xd[2];
#define FA_LOAD(IT) do { const int cc_ = (IT) & 63, g_ = ((IT) >> 6) & 3, b_ = (IT) >> 8; _Pragma("unroll") for (int i = 0; i < 2; ++i) { const int chunk = tid + 512 * i, r = chunk >> 3, ch = chunk & 7; \
        xd[i] = *(const GAS v4u*)(Fb + ((size_t)(b_ * 8192 + 64 * r + cc_) * 256 + g_ * 64 + ch * 8)); } } while (0)
#define FA_PUT() do { _Pragma("unroll") for (int i = 0; i < 2; ++i) { const int chunk = tid + 512 * i, r = chunk >> 3, ch = chunk & 7; *(LAS v4u*)(lds + r * XS + ch * 16) = xd[i]; } } while (0)
    if (vcu < 512) { FA_LOAD(vcu); FA_PUT(); }
    for (int it = vcu; it < 512; it += G) {
        const int cc = it & 63, g = (it >> 6) & 3, b = it >> 8;
        __syncthreads();
        f32x4 acc[8];
#pragma unroll
        for (int mt = 0; mt < 8; ++mt) { acc[mt] = (f32x4){0.f, 0.f, 0.f, 0.f};
#pragma unroll
            for (int ks = 0; ks < 2; ++ks) { const bf16x8 a = *(const LAS bf16x8*)(lds + (16 * mt + fr) * XS + (32 * ks + 8 * fq) * 2); acc[mt] = MFMA16(a, w1[ks], acc[mt]); } }
#pragma unroll
        for (int mt = 0; mt < 8; ++mt) { v2u o; o.x = pk2(acc[mt][0], acc[mt][1]); o.y = pk2(acc[mt][2], acc[mt][3]);
            *(LAS v2u*)(lds + T_OFF + (16 * w + fr) * TS + (16 * mt + 4 * fq) * 2) = o; }
        __syncthreads();
        if (it + G < 512) FA_LOAD(it + G);
        const float tph = (float)((k1 * cc) & 8191) * (1.0f / 8192.0f); const float tc = __builtin_amdgcn_cosf(tph), ts = __builtin_amdgcn_sinf(tph);
        bf16* yo = Yp + (((size_t)((b * 4 + g) * 128 + k1) * 2) * 64 + cc) * 64 + 4 * fq;
#pragma unroll
        for (int ct = 0; ct < 4; ++ct) { f32x4 p1 = (f32x4){0.f, 0.f, 0.f, 0.f}, p2 = p1, p34 = p1;
#pragma unroll
            for (int ks = 0; ks < 4; ++ks) {
                const bf16x8 aTc = *(const LAS bf16x8*)(lds + T_OFF + (16 * ct + fr) * TS + (32 * ks + 8 * fq) * 2);
                const bf16x8 aTs = *(const LAS bf16x8*)(lds + T_OFF + (64 + 16 * ct + fr) * TS + (32 * ks + 8 * fq) * 2);
                p1 = MFMA16(aTc, cb[ks], p1); p2 = MFMA16(aTs, sb[ks], p2); p34 = MFMA16(aTc, sb[ks], p34); p34 = MFMA16(aTs, cb[ks], p34); }
            const f32x4 yre = p1 - p2, yim = -p34; const f32x4 ore = yre * tc + yim * ts, oim = yim * tc - yre * ts;
            __hip_atomic_store((GAS unsigned long long*)(yo + 16 * ct), ((unsigned long long)pk2(ore[2], ore[3]) << 32) | pk2(ore[0], ore[1]), __ATOMIC_RELAXED, __HIP_MEMORY_SCOPE_AGENT);
            __hip_atomic_store((GAS unsigned long long*)(yo + 64 * 64 + 16 * ct), ((unsigned long long)pk2(oim[2], oim[3]) << 32) | pk2(oim[0], oim[1]), __ATOMIC_RELAXED, __HIP_MEMORY_SCOPE_AGENT); }
        if (it + G < 512) FA_PUT();
    }
    __syncthreads();
#undef FA_LOAD
#undef FA_PUT
}
__device__ __forceinline__ void fourier_b_phase(LAS unsigned char* lds, const bf16* Yp, bf16* AO, int vcu, int G, int tid) {
    asm volatile("" : "+v"(tid));
    const int lane = tid & 63, w = __builtin_amdgcn_readfirstlane(tid >> 6), fr = lane & 15, fq = lane >> 4, kt = w >> 1;
    constexpr int YS = 272;
    bf16x8 w2[4];
    const int k2 = 16 * kt + fr;
#pragma unroll
    for (int ks = 0; ks < 4; ++ks)
#pragma unroll
        for (int e = 0; e < 8; ++e) { const int K = 32 * ks + 8 * fq + e; const float ph = (float)((k2 * (K & 63)) & 63) * (1.0f / 64.0f);
            w2[ks][e] = (short)f2bf16((K >= 64 ? __builtin_amdgcn_sinf(ph) : __builtin_amdgcn_cosf(ph)) * 0.125f); }
    v4u yd[2];
#define FB_LOAD(IT) do { const bf16* src_ = Yp + (size_t)(((IT) >> 9) * 4 * 128 + (((IT) >> 7) & 3) * 128 + ((IT) & 127)) * 8192; _Pragma("unroll") for (int i = 0; i < 2; ++i) yd[i] = *(const GAS v4u*)(src_ + (size_t)(tid + 512 * i) * 8); } while (0)
    if (vcu < 1024) FB_LOAD(vcu);
    for (int it = vcu; it < 1024; it += G) {
        const int kk1 = it & 127, g = (it >> 7) & 3, b = it >> 9;
#pragma unroll
        for (int i = 0; i < 2; ++i) { const int chunk = tid + 512 * i, K = chunk >> 3, c0 = (chunk & 7) * 8;
            const v4u d = yd[i];
            LAS unsigned short* p = (LAS unsigned short*)(lds + c0 * YS + K * 2);
            p[0 * (YS / 2)] = (unsigned short)(d.x & 0xffffu); p[1 * (YS / 2)] = (unsigned short)(d.x >> 16); p[2 * (YS / 2)] = (unsigned short)(d.y & 0xffffu); p[3 * (YS / 2)] = (unsigned short)(d.y >> 16);
            p[4 * (YS / 2)] = (unsigned short)(d.z & 0xffffu); p[5 * (YS / 2)] = (unsigned short)(d.z >> 16); p[6 * (YS / 2)] = (unsigned short)(d.w & 0xffffu); p[7 * (YS / 2)] = (unsigned short)(d.w >> 16); }
        __syncthreads();
        if (it + G < 1024) FB_LOAD(it + G);
#pragma unroll
        for (int q = 0; q < 2; ++q) { const int ct = 2 * (w & 1) + q; f32x4 acc = (f32x4){0.f, 0.f, 0.f, 0.f};
#pragma unroll
            for (int ks = 0; ks < 4; ++ks) { const bf16x8 a = *(const LAS bf16x8*)(lds + (16 * ct + fr) * YS + (32 * ks + 8 * fq) * 2); acc = MFMA16(a, w2[ks], acc); }
            v2u o; o.x = pk2(acc[0], acc[1]); o.y = pk2(acc[2], acc[3]);
            *(GAS v2u*)(AO + (size_t)(b * 8192 + kk1 + 128 * k2) * 1024 + 768 + g * 64 + 16 * ct + 4 * fq) = o; }
        __syncthreads();
    }
#undef FB_LOAD
}

#define CAS __attribute__((address_space(4)))
#define PH_ARGS const CAS Args* ap = (const CAS Args*)__builtin_amdgcn_kernarg_segment_ptr(); asm volatile("" : "+s"(ap)); unsigned char* const ws = ap->ws; (void)ws
#define P_SS ((float*)(ws + WS_SS))
#define P_WB(l) ((bf16*)(ws + WS_W) + (size_t)((l) & 1) * W_LAYER_ELEMS)
#define P_XB ((bf16*)(ws + WS_XB))
#define P_Q ((bf16*)(ws + WS_Q))
#define P_K ((bf16*)(ws + WS_K))
#define P_V ((bf16*)(ws + WS_V))
#define P_F ((bf16*)(ws + WS_F))
#define P_G ((bf16*)(ws + WS_G))
#define P_AO ((bf16*)(ws + WS_AO))
#define P_YP ((bf16*)(ws + WS_YP))
#define P_MG ((bf16*)(ws + WS_MG))
#define P_H ((bf16*)(ws + WS_H))
__global__ void __launch_bounds__(NWAVES * 64, 2) fwd_kernel(Args args) {
    extern __shared__ __attribute__((aligned(16))) unsigned char lds_raw[];
    LAS unsigned char* lds = (LAS unsigned char*)lds_raw;
    cg::grid_group grid = cg::this_grid();
    const int G = gridDim.x; const int bx = blockIdx.x; const int vcu = (G % 8 == 0) ? (bx % 8) * (G / 8) + bx / 8 : bx;
    const int lo = args.ph_lo, hi = args.ph_hi;
    if (threadIdx.x < 32) ((volatile LAS unsigned*)(lds + MISC_OFF))[threadIdx.x] = 0u;
    __syncthreads();
    if (threadIdx.x == 0) __hip_atomic_store((unsigned*)(args.ws + WS_XTAB) + blockIdx.x, xb_xcc_id() + 1u, __ATOMIC_RELAXED, __HIP_MEMORY_SCOPE_AGENT);
#define IN(k) (lo <= (k) && (k) < hi)
#define GSEAM(k) do { if (IN(k) && IN((k) + 1)) { PH_ARGS; if (G == 256) group_barrier((unsigned*)(ws + WS_GCNT) + 64 * (bx & 63), (const unsigned*)(ws + WS_XTAB), (volatile LAS unsigned*)(lds + MISC_OFF) + 12); else { XcdBarrier xb_; xb_.bar = (unsigned*)(ws + WS_BAR); xb_.x = xb_xcc_id(); xb_.st = (volatile LAS unsigned*)(lds + MISC_OFF) + 8; xcd_barrier(xb_); } } } while (0)
#define SEAM(k) do { if (IN(k) && IN((k) + 1)) { PH_ARGS; XcdBarrier xb_; xb_.bar = (unsigned*)(ws + WS_BAR); xb_.x = xb_xcc_id(); xb_.st = (volatile LAS unsigned*)(lds + MISC_OFF) + 8; xcd_barrier(xb_); } } while (0)
#define WAVE_IDS int tid = threadIdx.x; asm volatile("" : "+v"(tid)); const int lane = tid & 63, wave = __builtin_amdgcn_readfirstlane(tid >> 6); const int gw = vcu * NWAVES + wave, NGW = G * NWAVES; (void)lane; (void)gw; (void)NGW
    if (IN(0)) {
        PH_ARGS; WAVE_IDS;
        convert_layer(ap, 0, P_WB(0), (LAS float*)(lds + 57344 + wave * 8448), gw, NGW, lane, 1);
        const float* x = ap->in[0]; float* SS = P_SS; bf16* XB = P_XB;
        for (int m = gw; m < M; m += 2 * NGW) {
            const int mb = (m + NGW < M) ? m + NGW : m;
            const GAS f32x4* xa = (const GAS f32x4*)(x + (size_t)m * D) + lane; const GAS f32x4* xc = (const GAS f32x4*)(x + (size_t)mb * D) + lane;
            f32x4 va[4], vb[4]; float sa = 0.f, sb = 0.f;
#pragma unroll
            for (int j = 0; j < 4; ++j) va[j] = xa[64 * j];
#pragma unroll
            for (int j = 0; j < 4; ++j) vb[j] = xc[64 * j];
#pragma unroll
            for (int j = 0; j < 4; ++j) { sa += pg8::hsum4(va[j] * va[j]); sb += pg8::hsum4(vb[j] * vb[j]); }
            sa = wave_sum(sa); sb = wave_sum(sb);
            GAS v2u* oa = (GAS v2u*)(XB + (size_t)m * D) + lane; GAS v2u* ob = (GAS v2u*)(XB + (size_t)mb * D) + lane;
#pragma unroll
            for (int j = 0; j < 4; ++j) { v2u o; o.x = pk2(va[j][0], va[j][1]); o.y = pk2(va[j][2], va[j][3]); oa[64 * j] = o; }
            if (lane < 16) SS[(size_t)m * 16 + lane] = (lane == 0) ? sa : 0.f;
            if (mb != m) {
#pragma unroll
                for (int j = 0; j < 4; ++j) { v2u o; o.x = pk2(vb[j][0], vb[j][1]); o.y = pk2(vb[j][2], vb[j][3]); ob[64 * j] = o; }
                if (lane < 16) SS[(size_t)mb * 16 + lane] = (lane == 0) ? sb : 0.f;
            }
        }
        if (blockIdx.x == 0) { unsigned* bw = (unsigned*)(ws + WS_BAR); for (int i = tid; i < XCD_BAR_WORDS; i += NWAVES * 64) bw[i] = 0u; }
        if (blockIdx.x == 0 && tid < DEPTH) ((unsigned*)(ws + WS_CNT))[64 * tid] = 0u;
        if (blockIdx.x == 0 && tid < 64) ((unsigned*)(ws + WS_GCNT))[64 * tid] = 0u;
    }
    if (IN(0) && IN(1)) {
        grid.sync();
        PH_ARGS; if (threadIdx.x == 0) (void)xb_add((unsigned*)(ws + WS_BAR) + XB_XCNT(xb_xcc_id()), 1u);
    }
#pragma unroll 1
    for (int l = 0; l < DEPTH; ++l) {
        const int pb = 1 + 7 * l;
        if (IN(pb)) {
            PH_ARGS;
            const pg8::PG8_LAS_F* rl = nullptr;
            if (G == 256) {
                const int pm_ = (bx & 7) * 8 + ((bx >> 3) & 7); const int t_ = threadIdx.x;
                if (t_ < 256) ((LAS float*)(lds + RSTD_OFF))[t_] = pg8::row_rstd(P_SS, pm_ * 256 + t_);
                __syncthreads(); rl = (const pg8::PG8_LAS_F*)(lds + RSTD_OFF);
            }
            pg8::Gemm g{P_XB, P_WB(l) + WO_IN, M, INW, D, D, D}; pg8::StaticOrder S; S.init(M, INW, G, bx);
            pg8::EpiInProj E{P_SS, P_Q, P_K, P_V, P_F, P_G, ap->in[4] + l * 64, ap->in[5] + l * 64, ap->in[3] + l * 2048, rl};
            pg8::gemm_phase<pg8::EpiInProj, pg8::StaticOrder, true, true>(lds, g, S, E);
            {
                WAVE_IDS; const int rem = ((M / 256) * (INW / 256)) % G;
                if (rem == 0) convert_layer(ap, l, P_WB(l), (LAS float*)(lds + 57344 + wave * 8448), gw, NGW, lane, 2);
                else if (bx >= rem) convert_layer(ap, l, P_WB(l), (LAS float*)(lds + 57344 + wave * 8448), (bx - rem) * NWAVES + wave, (G - rem) * NWAVES, lane, 2);
            }
        }
        SEAM(pb);
        if (IN(pb + 2)) {
            PH_ARGS; WAVE_IDS;
            unsigned* cnt = (unsigned*)(ws + WS_CNT) + 64 * l;
            fourier_a_phase(lds, P_F, P_YP, vcu, G, tid);
            asm volatile("s_waitcnt vmcnt(0)" ::: "memory"); __syncthreads();
            if (tid == 0) (void)xb_add(cnt, 1u);
            if (l + 1 < DEPTH) convert_layer(ap, l + 1, P_WB(l + 1), (LAS float*)(lds + 57344 + wave * 8448), gw, NGW, lane, 1);
            __syncthreads();
            const attn_body::AttnTensors AT{(const attn_body::bf16*)P_Q, (const attn_body::bf16*)P_K, (const attn_body::bf16*)P_V, (attn_body::bf16*)P_AO};
            attn_body::attn_phase<8>((char*)lds_raw, AT, vcu, G);
            if (tid == 0) { unsigned sp = 0; while (xb_ld(cnt) < (unsigned)G) { __builtin_amdgcn_s_sleep(2); if (++sp > (1u << 24)) break; }
                __builtin_amdgcn_fence(__ATOMIC_ACQUIRE, "agent"); asm volatile("s_waitcnt vmcnt(0)" ::: "memory"); }
            __syncthreads();
            fourier_b_phase(lds, P_YP, P_AO, vcu, G, tid);
        }
        SEAM(pb + 2);
        if (IN(pb + 3)) {
            PH_ARGS;
            pg8::Gemm g{P_AO, P_WB(l) + WO_AB, M, D, D, D, D}; pg8::StaticOrder S; S.init(M, D, G, bx);
            pg8::EpiBranchZ E{P_G, P_MG}; pg8::gemm_phase<pg8::EpiBranchZ, pg8::StaticOrder, true, true>(lds, g, S, E);
        }
        GSEAM(pb + 3);
        if (IN(pb + 4)) {
            PH_ARGS;
            pg8::Gemm g{P_MG, P_WB(l) + WO_OUT, M, D, D, D, D}; pg8::StaticOrder S; S.init(M, D, G, bx);
            pg8::EpiRes E{P_XB, P_SS}; pg8::gemm_phase<pg8::EpiRes, pg8::StaticOrder, true, true>(lds, g, S, E);
        }
        SEAM(pb + 4);
        if (IN(pb + 5)) {
            PH_ARGS;
            const pg8::PG8_LAS_F* rl = nullptr;
            if (G == 256) {
                const int pm_ = (bx & 7) * 8 + ((bx >> 3) & 7); const int t_ = threadIdx.x;
                if (t_ < 256) ((LAS float*)(lds + RSTD_OFF))[t_] = pg8::row_rstd(P_SS, pm_ * 256 + t_);
                __syncthreads(); rl = (const pg8::PG8_LAS_F*)(lds + RSTD_OFF);
            }
            pg8::Gemm g{P_XB, P_WB(l) + WO_UP, M, FF, D, D, D}; pg8::StaticOrder S; S.init(M, FF, G, bx);
            pg8::EpiUp E{P_SS, P_H, rl}; pg8::gemm_phase<pg8::EpiUp, pg8::StaticOrder, true, true>(lds, g, S, E);
        }
        GSEAM(pb + 5);
        if (IN(pb + 6)) {
            PH_ARGS;
            pg8::Gemm g{P_H, P_WB(l) + WO_DOWN, M, D, FF, FF, FF}; pg8::StaticOrder S; S.init(M, D, G, bx);
            if (l == DEPTH - 1 && G == 256 && IN(N_PHASES - 1)) {
                pg8::EpiResFinal E{P_XB, P_SS, ap->out, ap->in[12], (unsigned*)(ws + WS_GCNT) + 64 * (bx & 63), (pg8::PG8_LAS_F*)(lds + RSTD_OFF)};
                pg8::gemm_phase<pg8::EpiResFinal, pg8::StaticOrder, true, true>(lds, g, S, E);
            } else {
                pg8::EpiRes E{P_XB, P_SS}; pg8::gemm_phase<pg8::EpiRes, pg8::StaticOrder, true, true>(lds, g, S, E);
            }
        }
        if (!(l == DEPTH - 1 && G == 256)) SEAM(pb + 6);
    }
    if (IN(N_PHASES - 1) && G != 256) {
        PH_ARGS; WAVE_IDS;
        const float* gf = ap->in[12]; float* O = ap->out; const bf16* XBp = P_XB;
        f32x4 gv[2][2];
#pragma unroll
        for (int j = 0; j < 2; ++j) { gv[j][0] = *((const GAS f32x4*)gf + 2 * (lane + 64 * j)); gv[j][1] = *((const GAS f32x4*)gf + 2 * (lane + 64 * j) + 1); }
        for (int m = gw; m < M; m += 2 * NGW) {
            const int mb = (m + NGW < M) ? m + NGW : m;
            const GAS v4u* xa = (const GAS v4u*)(XBp + (size_t)m * D) + lane; const GAS v4u* xc = (const GAS v4u*)(XBp + (size_t)mb * D) + lane;
            v4u wa[2], wb[2];
#pragma unroll
            for (int j = 0; j < 2; ++j) { wa[j] = xa[64 * j]; wb[j] = xc[64 * j]; }
            f32x4 va[2][2], vb[2][2]; float sa = 0.f, sb = 0.f;
#pragma unroll
            for (int j = 0; j < 2; ++j) {
                va[j][0] = (f32x4){pg8::bf_lo(wa[j].x), pg8::bf_hi(wa[j].x), pg8::bf_lo(wa[j].y), pg8::bf_hi(wa[j].y)}; va[j][1] = (f32x4){pg8::bf_lo(wa[j].z), pg8::bf_hi(wa[j].z), pg8::bf_lo(wa[j].w), pg8::bf_hi(wa[j].w)};
                vb[j][0] = (f32x4){pg8::bf_lo(wb[j].x), pg8::bf_hi(wb[j].x), pg8::bf_lo(wb[j].y), pg8::bf_hi(wb[j].y)}; vb[j][1] = (f32x4){pg8::bf_lo(wb[j].z), pg8::bf_hi(wb[j].z), pg8::bf_lo(wb[j].w), pg8::bf_hi(wb[j].w)};
                sa += pg8::hsum4(va[j][0] * va[j][0]) + pg8::hsum4(va[j][1] * va[j][1]); sb += pg8::hsum4(vb[j][0] * vb[j][0]) + pg8::hsum4(vb[j][1] * vb[j][1]); }
            const float ra = rsqrtf(wave_sum(sa) * (1.0f / D) + 1e-6f), rb = rsqrtf(wave_sum(sb) * (1.0f / D) + 1e-6f);
            GAS f32x4* oa = (GAS f32x4*)(O + (size_t)m * D); GAS f32x4* ob = (GAS f32x4*)(O + (size_t)mb * D);
#pragma unroll
            for (int j = 0; j < 2; ++j) { oa[2 * (lane + 64 * j)] = va[j][0] * ra * gv[j][0]; oa[2 * (lane + 64 * j) + 1] = va[j][1] * ra * gv[j][1]; }
            if (mb != m) {
#pragma unroll
                for (int j = 0; j < 2; ++j) { ob[2 * (lane + 64 * j)] = vb[j][0] * rb * gv[j][0]; ob[2 * (lane + 64 * j) + 1] = vb[j][1] * rb * gv[j][1]; }
            }
        }
    }
#undef IN
#undef SEAM
}

extern "C" void kernel_launch(void* const* d_in, const int* in_sizes, int n_in, void* d_out, int out_size, void* d_ws, size_t ws_size, hipStream_t stream) {
    static int grid = 0;
    if (grid == 0) {
        if (n_in != 13 || in_sizes[0] != M * D || out_size != M * D || ws_size < WS_END) { fprintf(stderr, "kernel_launch: unexpected shapes (n_in %d, in0 %d, out %d, ws %zu)\n", n_in, n_in > 0 ? in_sizes[0] : -1, out_size, ws_size); grid = -1; return; }
        int dev = 0, cus = 0, per_cu = 0;
        if (hipGetDevice(&dev) != hipSuccess || hipDeviceGetAttribute(&cus, hipDeviceAttributeMultiprocessorCount, dev) != hipSuccess) { grid = -1; return; }
        if (hipFuncSetAttribute((const void*)fwd_kernel, hipFuncAttributeMaxDynamicSharedMemorySize, LDS_BYTES) != hipSuccess) { fprintf(stderr, "kernel_launch: hipFuncSetAttribute failed\n"); grid = -1; return; }
        if (hipOccupancyMaxActiveBlocksPerMultiprocessor(&per_cu, (const void*)fwd_kernel, NWAVES * 64, LDS_BYTES) != hipSuccess || per_cu < 1) per_cu = 1;
        (void)hipGetLastError();
        grid = cus * per_cu;
    }
    if (grid < 0) return;
    Args a{};
    for (int i = 0; i < 13; ++i) a.in[i] = (const float*)d_in[i];
    a.out = (float*)d_out; a.ws = (unsigned char*)d_ws;
#if MK_PER_PHASE
    for (int p = 0; p < N_PHASES; ++p) { a.ph_lo = p; a.ph_hi = p + 1; hipLaunchKernelGGL(fwd_kernel, dim3(grid), dim3(NWAVES * 64), LDS_BYTES, stream, a); }
#else
    a.ph_lo = 0; a.ph_hi = N_PHASES;
    void* kargs[] = {&a};
    const hipError_t e = hipLaunchCooperativeKernel((const void*)fwd_kernel, dim3(grid), dim3(NWAVES * 64), kargs, LDS_BYTES, stream);
    if (e != hipSuccess) fprintf(stderr, "kernel_launch: cooperative launch failed: %s (grid %d)\n", hipGetErrorString(e), grid);
#endif
}
```

```cpp
#include <hip/hip_runtime.h>
#include <hip/hip_cooperative_groups.h>
#include <cstdio>
#include <cstdint>
namespace cg = cooperative_groups;
namespace pg8 {
#define PG8_LAS __attribute__((address_space(3)))
typedef unsigned short bf16_t;
typedef short bf16x8 __attribute__((ext_vector_type(8)));
typedef float f32x4 __attribute__((ext_vector_type(4)));
typedef unsigned u32x4 __attribute__((ext_vector_type(4)));
constexpr int BM = 256, BK = 64, HALF = 128, HTB = HALF * BK * 2  , STAGE_BYTES = 8 * HTB, NXCD = 8, WGM = 8;

__host__ __device__ __forceinline__ int lds_byte(int r, int c) { const int st = (r >> 4) * 2 + (c >> 5), rr = r & 15, cc = c & 31, ob = rr * 64 + cc * 2; return st * 1024 + (ob ^ (((ob >> 9) & 1) << 5)); }
__host__ __device__ __forceinline__ void stage_rc(int b, int& R, int& C) { const int st = b / 1024, sb = b % 1024, swz = sb ^ (((sb >> 9) & 1) << 5); R = (st >> 1) * 16 + swz / 64; C = (st & 1) * 32 + (swz % 64) / 2; }
__host__ __device__ __forceinline__ int perm32(int rho) { const int n = rho >> 4, i = rho & 15; return 8 * (i >> 2) + 4 * n + (i & 3); }

struct Unit { int pm, pn; };
struct Gemm { const bf16_t* A; const bf16_t* Bt; int M, N, K, lda, ldb; };

struct StaticOrder {
    int nM, nN, nwg, G, c;
    __host__ __device__ void init(int M, int N, int G_, int c_) { nM = M / BM; nN = N / BM; nwg = nM * nN; G = G_; c = c_; }
    __host__ __device__ bool next(int i, Unit& u) const {
        const long L = (long)i * G + c; if (L >= nwg) return false;
        int wgid = (int)L; { const int q = nwg / NXCD, r = nwg % NXCD, xcd = wgid % NXCD, off = wgid / NXCD; wgid = (xcd < r ? xcd * (q + 1) : r * (q + 1) + (xcd - r) * q) + off; }
        const int nig = WGM * nN, gid = wgid / nig, fm = gid * WGM, gsz = (nM - fm) < WGM ? (nM - fm) : WGM;
        u.pm = fm + ((wgid % nig) % gsz); u.pn = (wgid % nig) / gsz; return true;
    }
    __device__ __forceinline__ void a_ready(const Unit&) const {}
    __device__ __forceinline__ void done(const Unit&) const {}
};
typedef float f32x2_cv __attribute__((ext_vector_type(2))); typedef __bf16 bf16x2_cv __attribute__((ext_vector_type(2)));
__device__ __forceinline__ unsigned cvt_pk_bf16(float lo, float hi) { f32x2_cv v = {lo, hi}; bf16x2_cv b = __builtin_convertvector(v, bf16x2_cv); return __builtin_bit_cast(unsigned, b); }
typedef float f32x2 __attribute__((ext_vector_type(2)));
typedef PG8_LAS float PG8_LAS_F;
constexpr float RMS_EPS = 1e-6f;
constexpr float ATT_C2 = 0.125f * 1.4426950408889634f;
__device__ __forceinline__ float bf_lo(unsigned w) { return __uint_as_float(w << 16); }
__device__ __forceinline__ float bf_hi(unsigned w) { return __uint_as_float(w & 0xffff0000u); }
__device__ __forceinline__ u32x4 pack8(const f32x4 a, const f32x4 b) { u32x4 w; w.x = cvt_pk_bf16(a[0], a[1]); w.y = cvt_pk_bf16(a[2], a[3]); w.z = cvt_pk_bf16(b[0], b[1]); w.w = cvt_pk_bf16(b[2], b[3]); return w; }
__device__ __forceinline__ float hsum4(const f32x4 a) { return (a[0] + a[1]) + (a[2] + a[3]); }
__device__ __forceinline__ float row_rstd(const float* ss, int row) {
    const f32x4* p = (const f32x4*)(ss + (size_t)row * 16);
    const float s = (hsum4(p[0]) + hsum4(p[1])) + (hsum4(p[2]) + hsum4(p[3]));
    return rsqrtf(s * (1.0f / 1024.0f) + RMS_EPS);
}
__device__ __forceinline__ void rows_scale(const PG8_LAS float* rl, const float* ss, int row0, int lrow, float (&rs)[2][4]) {
    if (rl) {
#pragma unroll
        for (int ai = 0; ai < 2; ++ai)
#pragma unroll
            for (int m = 0; m < 4; ++m) rs[ai][m] = rl[ai * HALF + m * 16 + lrow];
    } else {
#pragma unroll
        for (int ai = 0; ai < 2; ++ai)
#pragma unroll
            for (int m = 0; m < 4; ++m) rs[ai][m] = row_rstd(ss, row0 + ai * HALF + m * 16);
    }
}
struct EpiInProj {
    static constexpr bool PERM = true, AFTER_DRAIN = false; static constexpr int MIDT = 0;
    const float* ss; bf16_t *Q, *Kb, *Vb, *Fb, *G; const float *qg, *kg, *bgate; const PG8_LAS float* rl;
    __device__ __forceinline__ void operator()(const f32x4 (&acc)[2][2][4][2], const Unit& u, int wr, int wc, int fr, int fq) const {
        const int pn = u.pn; int row0 = u.pm * BM + wr * 64 + fr; asm volatile("" : "+v"(row0));
        float rsv[2][4]; rows_scale(rl, ss, row0, wr * 64 + fr, rsv);
        if (pn < 4) {
            const float* gp = (pn < 3) ? qg : kg;
            int fqo = fq; asm volatile("" : "+v"(fqo));
            float ifr[4];
#pragma unroll
            for (int j = 0; j < 4; ++j) ifr[j] = __builtin_amdgcn_exp2f(-(float)(4 * fqo + j) * (13.287712379549449f / 16.0f)) * 0.15915494309189535f;
            const float osc = (pn < 3) ? ATT_C2 : 1.0f;
            bf16_t* dst = (pn < 3) ? Q + (4 * pn + wc) * 64 : Kb + wc * 64; const int pitch = (pn < 3) ? 768 : 256;
#pragma unroll
            for (int ai = 0; ai < 2; ++ai)
#pragma unroll
                for (int m = 0; m < 4; ++m) {
                    const int row = row0 + ai * HALF + m * 16; const float rs = rsv[ai][m];
                    const int t = row & 8191; const float prow = (float)(t >> 6), pcol = (float)(t & 63);
                    float q = 0.f;
#pragma unroll
                    for (int bj = 0; bj < 2; ++bj)
#pragma unroll
                        for (int n = 0; n < 2; ++n) q += hsum4(acc[ai][bj][m][n] * acc[ai][bj][m][n]);
                    q += __shfl_xor(q, 16); q += __shfl_xor(q, 32);
                    const float hr = rs * rsqrtf(q * rs * rs * (1.0f / 64.0f) + RMS_EPS) * osc;
#pragma unroll
                    for (int bj = 0; bj < 2; ++bj) {
                        const float pos = bj ? pcol : prow; f32x4 o[2];
#pragma unroll
                        for (int n = 0; n < 2; ++n) {
                            const f32x4 gvv = *(const f32x4*)(gp + 32 * bj + 8 * fq + 4 * n); const f32x4 xv = acc[ai][bj][m][n] * hr * gvv;
#pragma unroll
                            for (int e = 0; e < 2; ++e) {
                                const float rev = pos * ifr[2 * n + e];
                                const float c = __builtin_amdgcn_cosf(rev), s = __builtin_amdgcn_sinf(rev);
                                o[n][2 * e] = xv[2 * e] * c - xv[2 * e + 1] * s; o[n][2 * e + 1] = xv[2 * e] * s + xv[2 * e + 1] * c;
                            }
                        }
                        *(u32x4*)(dst + (size_t)row * pitch + 32 * bj + 8 * fq) = pack8(o[0], o[1]);
                    }
                    asm volatile("" ::: "memory");
                }
        } else if (pn < 6) {
            bf16_t* dst = (pn == 4) ? Vb : Fb;
#pragma unroll
            for (int ai = 0; ai < 2; ++ai)
#pragma unroll
                for (int m = 0; m < 4; ++m) {
                    const int row = row0 + ai * HALF + m * 16; const float rs = rsv[ai][m];
#pragma unroll
                    for (int bj = 0; bj < 2; ++bj) *(u32x4*)(dst + (size_t)row * 256 + 128 * bj + 32 * wc + 8 * fq) = pack8(acc[ai][bj][m][0] * rs, acc[ai][bj][m][1] * rs);
                    asm volatile("" ::: "memory");
                }
        } else {
            int gc0 = (pn - 6) * 256 + 32 * wc + 8 * fq; asm volatile("" : "+v"(gc0));
            f32x4 bv[2][2];
#pragma unroll
            for (int bj = 0; bj < 2; ++bj)
#pragma unroll
                for (int n = 0; n < 2; ++n) bv[bj][n] = *(const f32x4*)(bgate + gc0 + 128 * bj + 4 * n);
#pragma unroll
            for (int ai = 0; ai < 2; ++ai)
#pragma unroll
                for (int m = 0; m < 4; ++m) {
                    const int row = row0 + ai * HALF + m * 16; const float rs = rsv[ai][m];
#pragma unroll
                    for (int bj = 0; bj < 2; ++bj) { f32x4 o[2];
#pragma unroll
                        for (int n = 0; n < 2; ++n) { const f32x4 x = acc[ai][bj][m][n] * rs + bv[bj][n];
#pragma unroll
                            for (int e = 0; e < 4; ++e) o[n][e] = __builtin_amdgcn_rcpf(1.0f + __builtin_amdgcn_exp2f(-1.4426950408889634f * x[e])); }
                        *(u32x4*)(G + (size_t)row * 2048 + gc0 + 128 * bj) = pack8(o[0], o[1]); }
                    asm volatile("" ::: "memory");
                }
        }
    }
};
template <int MODE> struct EpiBranch {
    static constexpr bool PERM = true, AFTER_DRAIN = false; static constexpr int MIDT = 0;
    const bf16_t* G; bf16_t* MG;
    __device__ __forceinline__ void operator()(const f32x4 (&acc)[2][2][4][2], const Unit& u, int wr, int wc, int fr, int fq) const {
        int row0 = u.pm * BM + wr * 64 + fr, col0 = u.pn * BM + 32 * wc + 8 * fq; asm volatile("" : "+v"(row0), "+v"(col0));
#pragma unroll
        for (int ai = 0; ai < 2; ++ai)
#pragma unroll
            for (int m = 0; m < 4; ++m) {
                const int row = row0 + ai * HALF + m * 16;
#pragma unroll
                for (int bj = 0; bj < 2; ++bj) {
                    const int col = col0 + 128 * bj;
                    const u32x4 gw = *(const u32x4*)(G + (size_t)row * 2048 + (MODE == 0 ? 1024 : 0) + col);
                    f32x4 o0, o1; const f32x4 a0 = acc[ai][bj][m][0], a1 = acc[ai][bj][m][1];
                    o0[0] = bf_lo(gw.x) * a0[0]; o0[1] = bf_hi(gw.x) * a0[1]; o0[2] = bf_lo(gw.y) * a0[2]; o0[3] = bf_hi(gw.y) * a0[3];
                    o1[0] = bf_lo(gw.z) * a1[0]; o1[1] = bf_hi(gw.z) * a1[1]; o1[2] = bf_lo(gw.w) * a1[2]; o1[3] = bf_hi(gw.w) * a1[3];
                    bf16_t* p = MG + (size_t)row * 1024 + col;
                    if (MODE == 1) { const u32x4 tw = *(const u32x4*)p;
                        o0[0] += bf_lo(tw.x); o0[1] += bf_hi(tw.x); o0[2] += bf_lo(tw.y); o0[3] += bf_hi(tw.y);
                        o1[0] += bf_lo(tw.z); o1[1] += bf_hi(tw.z); o1[2] += bf_lo(tw.w); o1[3] += bf_hi(tw.w); }
                    *(u32x4*)p = pack8(o0, o1);
                }
                asm volatile("" ::: "memory");
            }
    }
};
struct EpiBranchZ {
    static constexpr bool PERM = true, AFTER_DRAIN = false; static constexpr int MIDT = 12;
    const bf16_t* G; bf16_t* MG;
    __device__ __forceinline__ void mid(f32x4 (&acc)[2][2][4][2], const Unit& u, int wr, int wc, int fr, int fq) const {
        int row0 = u.pm * BM + wr * 64 + fr, col0 = u.pn * BM + 32 * wc + 8 * fq; asm volatile("" : "+v"(row0), "+v"(col0));
#pragma unroll
        for (int ai = 0; ai < 2; ++ai)
#pragma unroll
            for (int m = 0; m < 4; ++m) {
                const int row = row0 + ai * HALF + m * 16;
#pragma unroll
                for (int bj = 0; bj < 2; ++bj) {
                    const bf16_t* gp = G + (size_t)row * 2048 + col0 + 128 * bj;
                    const u32x4 ga = *(const u32x4*)gp, gf = *(const u32x4*)(gp + 1024);
                    f32x4& a0 = acc[ai][bj][m][0]; f32x4& a1 = acc[ai][bj][m][1];
#define BZ_R(A, F) ((A) * __builtin_amdgcn_rcpf(fmaxf((F), 1e-6f)))
                    a0[0] *= BZ_R(bf_lo(ga.x), bf_lo(gf.x)); a0[1] *= BZ_R(bf_hi(ga.x), bf_hi(gf.x)); a0[2] *= BZ_R(bf_lo(ga.y), bf_lo(gf.y)); a0[3] *= BZ_R(bf_hi(ga.y), bf_hi(gf.y));
                    a1[0] *= BZ_R(bf_lo(ga.z), bf_lo(gf.z)); a1[1] *= BZ_R(bf_hi(ga.z), bf_hi(gf.z)); a1[2] *= BZ_R(bf_lo(ga.w), bf_lo(gf.w)); a1[3] *= BZ_R(bf_hi(ga.w), bf_hi(gf.w));
#undef BZ_R
                }
                asm volatile("" ::: "memory");
            }
    }
    __device__ __forceinline__ void operator()(f32x4 (&acc)[2][2][4][2], const Unit& u, int wr, int wc, int fr, int fq) const {
        int row0 = u.pm * BM + wr * 64 + fr, col0 = u.pn * BM + 32 * wc + 8 * fq; asm volatile("" : "+v"(row0), "+v"(col0));
#pragma unroll
        for (int ai = 0; ai < 2; ++ai)
#pragma unroll
            for (int m = 0; m < 4; ++m) {
                int rb = row0 + ai * HALF + m * 16; asm volatile("" : "+v"(rb));
                const bf16_t* gp = G + (size_t)rb * 2048 + 1024 + col0;
                const u32x4 g0 = *(const u32x4*)gp, g1 = *(const u32x4*)(gp + 128);
#define BZ_M(A, GW) { f32x4& a0 = A[0]; f32x4& a1 = A[1]; a0[0] *= fmaxf(bf_lo(GW.x), 1e-6f); a0[1] *= fmaxf(bf_hi(GW.x), 1e-6f); a0[2] *= fmaxf(bf_lo(GW.y), 1e-6f); a0[3] *= fmaxf(bf_hi(GW.y), 1e-6f); \
                      a1[0] *= fmaxf(bf_lo(GW.z), 1e-6f); a1[1] *= fmaxf(bf_hi(GW.z), 1e-6f); a1[2] *= fmaxf(bf_lo(GW.w), 1e-6f); a1[3] *= fmaxf(bf_hi(GW.w), 1e-6f); }
                BZ_M(acc[ai][0][m], g0) BZ_M(acc[ai][1][m], g1)
#undef BZ_M
                asm volatile("" : "+v"(acc[ai][0][m][0]), "+v"(acc[ai][0][m][1]), "+v"(acc[ai][1][m][0]), "+v"(acc[ai][1][m][1]) :: "memory");
            }
#pragma unroll
        for (int ai = 0; ai < 2; ++ai)
#pragma unroll
            for (int m = 0; m < 4; ++m) {
                int row = row0 + ai * HALF + m * 16; asm volatile("" : "+v"(row));
                bf16_t* p = MG + (size_t)row * 1024 + col0;
                *(u32x4*)p = pack8(acc[ai][0][m][0], acc[ai][0][m][1]); *(u32x4*)(p + 128) = pack8(acc[ai][1][m][0], acc[ai][1][m][1]);
            }
    }
};
struct EpiRes {
    static constexpr bool PERM = true, AFTER_DRAIN = false; static constexpr int MIDT = 0;
    bf16_t* xb; float* ss;
    __device__ __forceinline__ void operator()(f32x4 (&acc)[2][2][4][2], const Unit& u, int wr, int wc, int fr, int fq) const {
        int row0 = u.pm * BM + wr * 64 + fr, col0 = u.pn * BM + 32 * wc + 8 * fq; asm volatile("" : "+v"(row0), "+v"(col0));
#pragma unroll
        for (int ai = 0; ai < 2; ++ai)
#pragma unroll
          for (int m = 0; m < 4; ++m) {
            int rb = row0 + ai * HALF + 16 * m; asm volatile("" : "+v"(rb));
            const bf16_t* p = xb + (size_t)rb * 1024 + col0;
            const u32x4 b0 = *(const u32x4*)p, b1 = *(const u32x4*)(p + 128);
            f32x4& a00 = acc[ai][0][m][0]; f32x4& a01 = acc[ai][0][m][1]; f32x4& a10 = acc[ai][1][m][0]; f32x4& a11 = acc[ai][1][m][1];
            a00[0] += bf_lo(b0.x); a00[1] += bf_hi(b0.x); a00[2] += bf_lo(b0.y); a00[3] += bf_hi(b0.y); a01[0] += bf_lo(b0.z); a01[1] += bf_hi(b0.z); a01[2] += bf_lo(b0.w); a01[3] += bf_hi(b0.w);
            a10[0] += bf_lo(b1.x); a10[1] += bf_hi(b1.x); a10[2] += bf_lo(b1.y); a10[3] += bf_hi(b1.y); a11[0] += bf_lo(b1.z); a11[1] += bf_hi(b1.z); a11[2] += bf_lo(b1.w); a11[3] += bf_hi(b1.w);
            asm volatile("" : "+v"(acc[ai][0][m][0]), "+v"(acc[ai][0][m][1]), "+v"(acc[ai][1][m][0]), "+v"(acc[ai][1][m][1]) :: "memory"); }
#pragma unroll
        for (int ai = 0; ai < 2; ++ai)
#pragma unroll
            for (int m = 0; m < 4; ++m) {
                int row = row0 + ai * HALF + m * 16; asm volatile("" : "+v"(row)); float q = 0.f;
                bf16_t* pb = xb + (size_t)row * 1024 + col0;
#pragma unroll
                for (int bj = 0; bj < 2; ++bj) {
                    const f32x4 o0 = acc[ai][bj][m][0], o1 = acc[ai][bj][m][1];
                    *(u32x4*)(pb + 128 * bj) = pack8(o0, o1);
                    q += hsum4(o0 * o0) + hsum4(o1 * o1);
                }
                q += __shfl_xor(q, 16); q += __shfl_xor(q, 32);
                if (fq == 0) ss[(size_t)row * 16 + 4 * u.pn + wc] = q;
                asm volatile("" ::: "memory");
            }
    }
};
struct EpiResFinal {
    static constexpr bool PERM = true, AFTER_DRAIN = false; static constexpr int MIDT = 0;
    const bf16_t* xb; float* ss; float* out; const float* gfin; unsigned* gcnt; PG8_LAS float* tab;
    __device__ __forceinline__ void operator()(f32x4 (&acc)[2][2][4][2], const Unit& u, int wr, int wc, int fr, int fq) const {
        int row0 = u.pm * BM + wr * 64 + fr, col0 = u.pn * BM + 32 * wc + 8 * fq; asm volatile("" : "+v"(row0), "+v"(col0));
#pragma unroll
        for (int ai = 0; ai < 2; ++ai)
#pragma unroll
          for (int m = 0; m < 4; ++m) {
            int rb = row0 + ai * HALF + 16 * m; asm volatile("" : "+v"(rb));
            const bf16_t* p = xb + (size_t)rb * 1024 + col0;
            const u32x4 b0 = *(const u32x4*)p, b1 = *(const u32x4*)(p + 128);
            f32x4& a00 = acc[ai][0][m][0]; f32x4& a01 = acc[ai][0][m][1]; f32x4& a10 = acc[ai][1][m][0]; f32x4& a11 = acc[ai][1][m][1];
            a00[0] += bf_lo(b0.x); a00[1] += bf_hi(b0.x); a00[2] += bf_lo(b0.y); a00[3] += bf_hi(b0.y); a01[0] += bf_lo(b0.z); a01[1] += bf_hi(b0.z); a01[2] += bf_lo(b0.w); a01[3] += bf_hi(b0.w);
            a10[0] += bf_lo(b1.x); a10[1] += bf_hi(b1.x); a10[2] += bf_lo(b1.y); a10[3] += bf_hi(b1.y); a11[0] += bf_lo(b1.z); a11[1] += bf_hi(b1.z); a11[2] += bf_lo(b1.w); a11[3] += bf_hi(b1.w);
            asm volatile("" : "+v"(acc[ai][0][m][0]), "+v"(acc[ai][0][m][1]), "+v"(acc[ai][1][m][0]), "+v"(acc[ai][1][m][1]) :: "memory"); }
#pragma unroll
        for (int ai = 0; ai < 2; ++ai)
#pragma unroll
            for (int m = 0; m < 4; ++m) {
                int row = row0 + ai * HALF + m * 16; asm volatile("" : "+v"(row)); float q = 0.f;
#pragma unroll
                for (int bj = 0; bj < 2; ++bj) q += hsum4(acc[ai][bj][m][0] * acc[ai][bj][m][0]) + hsum4(acc[ai][bj][m][1] * acc[ai][bj][m][1]);
                q += __shfl_xor(q, 16); q += __shfl_xor(q, 32);
                if (fq == 0) ss[(size_t)row * 16 + 4 * u.pn + wc] = q;
            }
        asm volatile("s_waitcnt vmcnt(0)" ::: "memory");
        __syncthreads();
        if (threadIdx.x == 0) {
            __builtin_amdgcn_fence(__ATOMIC_RELEASE, "agent"); asm volatile("s_waitcnt vmcnt(0)" ::: "memory");
            const unsigned old = __hip_atomic_fetch_add(gcnt, 1u, __ATOMIC_RELAXED, __HIP_MEMORY_SCOPE_AGENT), target = (old / 4u + 1u) * 4u; unsigned sp = 0;
            while (__hip_atomic_load(gcnt, __ATOMIC_RELAXED, __HIP_MEMORY_SCOPE_AGENT) < target) { __builtin_amdgcn_s_sleep(1); if (++sp > (1u << 24)) break; }
            __builtin_amdgcn_fence(__ATOMIC_ACQUIRE, "agent"); asm volatile("s_waitcnt vmcnt(0)" ::: "memory");
        }
        __syncthreads();
        if (threadIdx.x < 256) tab[threadIdx.x] = row_rstd(ss, u.pm * BM + (int)threadIdx.x);
        __syncthreads();
        float rsv[2][4];
#pragma unroll
        for (int ai = 0; ai < 2; ++ai)
#pragma unroll
            for (int m = 0; m < 4; ++m) rsv[ai][m] = tab[ai * HALF + wr * 64 + m * 16 + fr];
        f32x4 gv[2][2];
#pragma unroll
        for (int bj = 0; bj < 2; ++bj)
#pragma unroll
            for (int n = 0; n < 2; ++n) { gv[bj][n] = *(const f32x4*)(gfin + col0 + 128 * bj + 4 * n); asm volatile("" : "+v"(gv[bj][n])); }
        asm volatile("" ::: "memory");
#pragma unroll
        for (int ai = 0; ai < 2; ++ai)
#pragma unroll
            for (int m = 0; m < 4; ++m) {
                int row = row0 + ai * HALF + m * 16; asm volatile("" : "+v"(row)); const float rs = rsv[ai][m];
                float* po = out + (size_t)row * 1024 + col0;
#pragma unroll
                for (int bj = 0; bj < 2; ++bj) { *(f32x4*)(po + 128 * bj) = acc[ai][bj][m][0] * rs * gv[bj][0]; *(f32x4*)(po + 128 * bj + 4) = acc[ai][bj][m][1] * rs * gv[bj][1]; }
            }
    }
};
struct EpiUp {
    static constexpr bool PERM = true, AFTER_DRAIN = false; static constexpr int MIDT = 0;
    const float* ss; bf16_t* H; const PG8_LAS float* rl;
    __device__ __forceinline__ void operator()(const f32x4 (&acc)[2][2][4][2], const Unit& u, int wr, int wc, int fr, int fq) const {
        int row0 = u.pm * BM + wr * 64 + fr, col0 = u.pn * BM + 32 * wc + 8 * fq; asm volatile("" : "+v"(row0), "+v"(col0));
        const __amdgpu_buffer_rsrc_t hrs = __builtin_amdgcn_make_buffer_rsrc(H, 0, 0x08000000, 0x00020000);
        float rsv[2][4]; rows_scale(rl, ss, row0, wr * 64 + fr, rsv);
#pragma unroll
        for (int ai = 0; ai < 2; ++ai)
#pragma unroll
            for (int m = 0; m < 4; ++m) {
                const int row = row0 + ai * HALF + m * 16; const float rs = rsv[ai][m];
#pragma unroll
                for (int bj = 0; bj < 2; ++bj) { f32x4 o[2];
#pragma unroll
                    for (int n = 0; n < 2; ++n) { const f32x4 x = acc[ai][bj][m][n] * rs;
#pragma unroll
                        for (int e = 0; e < 4; ++e) { const float r = fmaxf(x[e], 0.f); o[n][e] = r * r; } }
                    __builtin_amdgcn_raw_buffer_store_b128(pack8(o[0], o[1]), hrs, (unsigned)(((size_t)row * 4096 + col0 + 128 * bj) * 2), 0, 16); }
                asm volatile("" ::: "memory");
            }
    }
};
template <class Epi, class Sched, bool ALIGN_EPI = false, bool SP2 = false>
__device__ __forceinline__ void gemm_phase(PG8_LAS unsigned char* lds, const Gemm g, const Sched& S, const Epi& E) {
    int tid_o = threadIdx.x; asm volatile("" : "+v"(tid_o));
    const int tid = tid_o, wid = __builtin_amdgcn_readfirstlane(tid >> 6), lane = tid & 63, wr = wid >> 2, wc = wid & 3, fr = lane & 15, fq = lane >> 4;
    const int K = g.K, nt = K / BK;
    unsigned voffA[2], voffB[2];
#pragma unroll
    for (int i = 0; i < 2; ++i) { int R, C; stage_rc(tid * 16 + i * 8192, R, C); const int Rb = Epi::PERM ? ((R & ~31) + perm32(R & 31)) : R;
        voffA[i] = (unsigned)(R * g.lda + C) * 2u; voffB[i] = (unsigned)(Rb * g.ldb + C) * 2u; }
    const size_t kstep = (size_t)(BK * 2);
    const size_t hstepA = (size_t)HALF * g.lda * 2, hstepB = (size_t)HALF * g.ldb * 2;
    const size_t tstepA = 2 * hstepA, tstepB = 2 * hstepB;
    const unsigned ldsw = (unsigned)wid * 1024u;
    const int aoff = lds_byte(wr * 64 + fr, fq * 8), boff = lds_byte(wc * 32 + fr, fq * 8);
#define PG8_SA(b, h) (((b) * 2 + (h)) * HTB)
#define PG8_SB(b, h) ((4 + (b) * 2 + (h)) * HTB)
#define PG8_STAGE(bufoff, gbase, voff) do { _Pragma("unroll") for (int _i = 0; _i < 2; ++_i) \
        __builtin_amdgcn_global_load_lds((const unsigned*)((const char*)(gbase) + (voff)[_i]), (PG8_LAS unsigned*)(lds + (bufoff) + ldsw + _i * 8192), 16, 0, 0); } while (0)
#define PG8_LDA(dst, b, h) do { _Pragma("unroll") for (int m = 0; m < 4; ++m) _Pragma("unroll") for (int k = 0; k < 2; ++k) dst[m][k] = *(const PG8_LAS bf16x8*)(lds + PG8_SA(b, h) + aoff + m * 2048 + k * 1024); } while (0)
#define PG8_LDB(dst, b, h) do { _Pragma("unroll") for (int n = 0; n < 2; ++n) _Pragma("unroll") for (int k = 0; k < 2; ++k) dst[n][k] = *(const PG8_LAS bf16x8*)(lds + PG8_SB(b, h) + boff + n * 2048 + k * 1024); } while (0)
#define PG8_MMA(ai, bj, At, Bt) do { __builtin_amdgcn_s_setprio(1); _Pragma("unroll") for (int m = 0; m < 4; ++m) _Pragma("unroll") for (int n = 0; n < 2; ++n) _Pragma("unroll") for (int k = 0; k < 2; ++k) \
        acc[ai][bj][m][n] = __builtin_amdgcn_mfma_f32_16x16x32_bf16(Bt[n][k], At[m][k], acc[ai][bj][m][n], 0, 0, 0); __builtin_amdgcn_s_setprio(0); } while (0)
#define PG8_WAIT_V(n) asm volatile("s_waitcnt vmcnt(" #n ")" ::: "memory")
#define PG8_WAIT_L(n) asm volatile("s_waitcnt lgkmcnt(" #n ")" ::: "memory")
#define PG8_BAR __builtin_amdgcn_s_barrier()
#define PG8_SCHED __builtin_amdgcn_sched_barrier(0)
    Unit cur, nxt; int ui = 0;
    if (!S.next(0, cur)) return;
    f32x4 acc[2][2][4][2];
#pragma unroll
    for (int a = 0; a < 2; ++a)
#pragma unroll
        for (int b = 0; b < 2; ++b)
#pragma unroll
            for (int m = 0; m < 4; ++m)
#pragma unroll
                for (int n = 0; n < 2; ++n) acc[a][b][m][n] = (f32x4){0.f, 0.f, 0.f, 0.f};
    bf16x8 At[4][2], B0[2][2], B1[2][2];
    const char* cA = (const char*)g.A + (size_t)cur.pm * tstepA; const char* cB = (const char*)g.Bt + (size_t)cur.pn * tstepB;
    S.a_ready(cur);
    if constexpr (SP2) {
        PG8_STAGE(PG8_SB(0, 0), cB, voffB); PG8_STAGE(PG8_SB(0, 1), cB + hstepB, voffB); PG8_STAGE(PG8_SA(0, 0), cA, voffA); PG8_STAGE(PG8_SA(0, 1), cA + hstepA, voffA);
        if (wr == 1) PG8_BAR;
        PG8_WAIT_V(2); PG8_BAR;
        PG8_STAGE(PG8_SB(1, 0), cB + kstep, voffB); PG8_STAGE(PG8_SA(1, 0), cA + kstep, voffA); PG8_STAGE(PG8_SB(1, 1), cB + hstepB + kstep, voffB);
        PG8_WAIT_V(6); PG8_BAR;
    } else {
        PG8_STAGE(PG8_SB(0, 0), cB, voffB); PG8_STAGE(PG8_SA(0, 0), cA, voffA); PG8_STAGE(PG8_SB(0, 1), cB + hstepB, voffB); PG8_STAGE(PG8_SA(0, 1), cA + hstepA, voffA);
        if (wr == 1) PG8_BAR;
        PG8_WAIT_V(4); PG8_BAR;
        PG8_STAGE(PG8_SB(1, 0), cB + kstep, voffB); PG8_STAGE(PG8_SA(1, 0), cA + kstep, voffA); PG8_STAGE(PG8_SB(1, 1), cB + hstepB + kstep, voffB);
        PG8_WAIT_V(6); PG8_BAR;
    }
    for (;;) {
        const bool has_next = S.next(ui + 1, nxt);
        const char* nA = has_next ? (const char*)g.A + (size_t)nxt.pm * tstepA : cA; const char* nB = has_next ? (const char*)g.Bt + (size_t)nxt.pn * tstepB : cB;
        for (int t = 0; t < nt; t += 2) {
            if constexpr (Epi::MIDT > 0) { if (t == Epi::MIDT) E.mid(acc, cur, wr, wc, fr, fq); }
            const bool last = (t == nt - 2);
            const char* a1 = cA + (size_t)(t + 1) * kstep;
            const char* a2 = last ? nA : cA + (size_t)(t + 2) * kstep; const char* b2 = last ? nB : cB + (size_t)(t + 2) * kstep;
            const char* a3 = a2 + kstep; const char* b3 = b2 + kstep;
            if (last && has_next) S.a_ready(nxt);
            if constexpr (SP2) {
            PG8_LDB(B0, 0, 0); PG8_LDB(B1, 0, 1); PG8_SCHED; PG8_LDA(At, 0, 0); PG8_STAGE(PG8_SA(1, 1), a1 + hstepA, voffA);
            PG8_WAIT_V(8); PG8_WAIT_L(0); PG8_BAR; PG8_MMA(0, 0, At, B0); PG8_MMA(0, 1, At, B1); PG8_BAR; PG8_SCHED;
            PG8_LDA(At, 0, 1); PG8_STAGE(PG8_SB(0, 0), b2, voffB); PG8_STAGE(PG8_SB(0, 1), b2 + hstepB, voffB); PG8_STAGE(PG8_SA(0, 0), a2, voffA);
            PG8_WAIT_V(8); PG8_WAIT_L(0); PG8_BAR; PG8_MMA(1, 0, At, B0); PG8_MMA(1, 1, At, B1); PG8_BAR; PG8_SCHED;
            PG8_LDB(B0, 1, 0); PG8_LDB(B1, 1, 1); PG8_SCHED; PG8_LDA(At, 1, 0); PG8_STAGE(PG8_SA(0, 1), a2 + hstepA, voffA);
            PG8_WAIT_V(8); PG8_WAIT_L(0); PG8_BAR; PG8_MMA(0, 0, At, B0); PG8_MMA(0, 1, At, B1); PG8_BAR; PG8_SCHED;
            PG8_LDA(At, 1, 1); PG8_STAGE(PG8_SB(1, 0), b3, voffB); PG8_STAGE(PG8_SB(1, 1), b3 + hstepB, voffB); PG8_STAGE(PG8_SA(1, 0), a3, voffA);
            PG8_WAIT_V(8); PG8_WAIT_L(0); PG8_BAR; PG8_MMA(1, 0, At, B0); PG8_MMA(1, 1, At, B1); PG8_BAR; PG8_SCHED;
            } else {
            PG8_LDB(B0, 0, 0); PG8_SCHED; PG8_LDA(At, 0, 0); PG8_STAGE(PG8_SA(1, 1), a1 + hstepA, voffA);
            PG8_WAIT_L(8); PG8_BAR; PG8_WAIT_L(0); PG8_MMA(0, 0, At, B0); PG8_BAR; PG8_SCHED;
            PG8_LDB(B1, 0, 1); PG8_STAGE(PG8_SB(0, 0), b2, voffB);
            PG8_BAR; PG8_WAIT_L(0); PG8_MMA(0, 1, At, B1); PG8_BAR;
            PG8_LDA(At, 0, 1); PG8_STAGE(PG8_SA(0, 0), a2, voffA);
            PG8_BAR; PG8_WAIT_L(0); PG8_MMA(1, 0, At, B0); PG8_BAR; PG8_SCHED;
            PG8_STAGE(PG8_SB(0, 1), b2 + hstepB, voffB);
            PG8_WAIT_V(6); PG8_BAR; PG8_MMA(1, 1, At, B1); PG8_BAR;
            PG8_LDB(B0, 1, 0); PG8_SCHED; PG8_LDA(At, 1, 0); PG8_STAGE(PG8_SA(0, 1), a2 + hstepA, voffA);
            PG8_WAIT_L(8); PG8_BAR; PG8_WAIT_L(0); PG8_MMA(0, 0, At, B0); PG8_BAR; PG8_SCHED;
            PG8_LDB(B1, 1, 1); PG8_STAGE(PG8_SB(1, 0), b3, voffB);
            PG8_BAR; PG8_WAIT_L(0); PG8_MMA(0, 1, At, B1); PG8_BAR;
            PG8_LDA(At, 1, 1); PG8_STAGE(PG8_SA(1, 0), a3, voffA);
            PG8_BAR; PG8_WAIT_L(0); PG8_MMA(1, 0, At, B0); PG8_BAR; PG8_SCHED;
            PG8_STAGE(PG8_SB(1, 1), b3 + hstepB, voffB);
            PG8_WAIT_V(6); PG8_BAR; PG8_MMA(1, 1, At, B1); PG8_BAR;
            }
        }
        if constexpr (ALIGN_EPI) { if (wr == 0) PG8_BAR; }
        if constexpr (!Epi::AFTER_DRAIN) { E(acc, cur, wr, wc, fr, fq); S.done(cur); }
        if (!has_next) break;
#pragma unroll
        for (int a = 0; a < 2; ++a)
#pragma unroll
            for (int b = 0; b < 2; ++b)
#pragma unroll
                for (int m = 0; m < 4; ++m)
#pragma unroll
                    for (int n = 0; n < 2; ++n) acc[a][b][m][n] = (f32x4){0.f, 0.f, 0.f, 0.f};
        cur = nxt; cA = nA; cB = nB; ++ui;
        if constexpr (ALIGN_EPI) { if (wr == 1) PG8_BAR; }
    }
    PG8_WAIT_V(0);
    if constexpr (!ALIGN_EPI) { if (wr == 0) PG8_BAR; }
    PG8_BAR;
    if constexpr (Epi::AFTER_DRAIN) { E.fused(acc, cur, wr, wc, fr, fq, lds, wid, lane); S.done(cur); }
#undef PG8_SA
#undef PG8_SB
#undef PG8_STAGE
#undef PG8_LDA
#undef PG8_LDB
#undef PG8_MMA
#undef PG8_WAIT_V
#undef PG8_WAIT_L
#undef PG8_BAR
#undef PG8_SCHED
}
}
#include <hip/hip_bf16.h>
#include <cmath>
namespace attn_body {
using bf16=__hip_bfloat16;
using bf16x8=__attribute__((ext_vector_type(8)))short;
using s16x4=__attribute__((ext_vector_type(4)))short;
using f32x16=__attribute__((ext_vector_type(16)))float;
using u32x4=__attribute__((ext_vector_type(4)))unsigned;
constexpr int BATCH=2,SEQ=8192,D=64,QP=768,KVP=256,OP=1024;
constexpr int NW=8,QBLK=32,QB=QBLK*NW,KVBLK=64,NQB=SEQ/QB;
constexpr int ATTN_UNIT_ROWS=QB;
__device__ __forceinline__ int crow(int r,int hi){return (r&3)+8*(r>>2)+4*hi;}
#define SBAR() __builtin_amdgcn_sched_barrier(0)
__device__ __forceinline__ void cmask(f32x16&p0,f32x16&p1,int jb,int qrel,int hi){
  const float NEG=-INFINITY; int kb=64*jb+4*hi;
  #pragma unroll
  for(int r=0;r<16;++r){int kv=kb+(r&3)+8*(r>>2); if(kv>qrel)p0[r]=NEG; if(kv+32>qrel)p1[r]=NEG;}
}

constexpr int NSLOT=3, SLOTB=8192;
constexpr int LDS_K=0, LDS_V=NSLOT*SLOTB, LDS_WS=2*NSLOT*SLOTB, LDS_OST=LDS_WS+NW*64*4, LDS_BYTES=LDS_OST+NW*4096;
constexpr float C2=0.125f*1.4426950408889634f;
__device__ __forceinline__ void glds16(const void*gsrc,unsigned lds_dst){unsigned keep;
  asm volatile("s_mov_b32 %0, m0\n\ts_mov_b32 m0, %2\n\ts_nop 0\n\tglobal_load_lds_dwordx4 %1, off\n\ts_mov_b32 m0, %0":"=&s"(keep):"v"(gsrc),"s"(lds_dst):"memory");}
__device__ __forceinline__ float max3f(float a,float b,float c){float r;asm("v_max3_f32 %0, %1, %2, %3":"=v"(r):"v"(a),"v"(b),"v"(c));return r;}
__device__ __forceinline__ float max2f(float a,float b){float r;asm("v_max_f32_e32 %0, %1, %2":"=v"(r):"v"(a),"v"(b));return r;}
__device__ __forceinline__ float fadd_s(float a,float b){float r;asm("v_add_f32_e32 %0, %1, %2":"=v"(r):"v"(a),"v"(b));return r;}
__device__ __forceinline__ float fsub_s(float a,float b){float r;asm("v_sub_f32_e32 %0, %1, %2":"=v"(r):"v"(a),"v"(b));return r;}
typedef float f32x2_t __attribute__((ext_vector_type(2))); typedef __bf16 bf16x2_t __attribute__((ext_vector_type(2)));
__device__ __forceinline__ unsigned cvtpk_s(float lo,float hi){f32x2_t v={lo,hi};bf16x2_t b=__builtin_convertvector(v,bf16x2_t);return __builtin_bit_cast(unsigned,b);}
#define WAIT_BAR(N) asm volatile("s_waitcnt vmcnt(" #N ") lgkmcnt(0)\n\ts_barrier":::"memory")

__device__ __forceinline__ void qkt(f32x16&p0,f32x16&p1,const char*Kslot,const bf16x8*qr,const f32x16&negm,int r32,int hi){
  const char*kb=Kslot+hi*1024+r32*16;
  #pragma unroll
  for(int d0=0;d0<4;++d0){
    const bf16x8 b0=*reinterpret_cast<const bf16x8*>(kb+d0*2048);
    const bf16x8 b1=*reinterpret_cast<const bf16x8*>(kb+d0*2048+512);
    if(d0==0){p0=__builtin_amdgcn_mfma_f32_32x32x16_bf16(b0,qr[0],negm,0,0,0);p1=__builtin_amdgcn_mfma_f32_32x32x16_bf16(b1,qr[0],negm,0,0,0);}
    else{p0=__builtin_amdgcn_mfma_f32_32x32x16_bf16(b0,qr[d0],p0,0,0,0);p1=__builtin_amdgcn_mfma_f32_32x32x16_bf16(b1,qr[d0],p1,0,0,0);}}
}
typedef __attribute__((address_space(3))) const char* lds_cptr;
typedef short v4i16_t __attribute__((ext_vector_type(4)));
__device__ __forceinline__ void kload8(bf16x8*kf,lds_cptr kp){
  kf[0]=*(const __attribute__((address_space(3))) bf16x8*)(kp);      kf[1]=*(const __attribute__((address_space(3))) bf16x8*)(kp+512);
  kf[2]=*(const __attribute__((address_space(3))) bf16x8*)(kp+2048); kf[3]=*(const __attribute__((address_space(3))) bf16x8*)(kp+2560);
  kf[4]=*(const __attribute__((address_space(3))) bf16x8*)(kp+4096); kf[5]=*(const __attribute__((address_space(3))) bf16x8*)(kp+4608);
  kf[6]=*(const __attribute__((address_space(3))) bf16x8*)(kp+6144); kf[7]=*(const __attribute__((address_space(3))) bf16x8*)(kp+6656);
}
__device__ __forceinline__ void kload2(bf16x8*kf,lds_cptr kp,int j){ kf[2*j]=*(const __attribute__((address_space(3))) bf16x8*)(kp+j*2048); kf[2*j+1]=*(const __attribute__((address_space(3))) bf16x8*)(kp+j*2048+512); }
__device__ __forceinline__ s16x4 vtr(lds_cptr p){ return __builtin_bit_cast(s16x4,__builtin_amdgcn_ds_read_tr16_b64_v4i16((__attribute__((address_space(3))) v4i16_t*)p)); }
__device__ __forceinline__ float rowmax(const f32x16&p0,const f32x16&p1){
  float a=max3f(p0[0],p0[1],p1[0]),b=max3f(p0[2],p0[3],p1[1]);a=max3f(a,p1[2],p1[3]);
  #pragma unroll
  for(int r=4;r<16;r+=4){a=max3f(a,p0[r],p0[r+1]);b=max3f(b,p0[r+2],p0[r+3]);a=max3f(a,p1[r],p1[r+1]);b=max3f(b,p1[r+2],p1[r+3]);}
  const float m=max2f(a,b);
  auto rr=__builtin_amdgcn_permlane32_swap(__float_as_uint(m),__float_as_uint(m),false,false);
  return max2f(__uint_as_float(rr[0]),__uint_as_float(rr[1]));
}
__device__ __forceinline__ void pv(f32x16*o,int vb,bf16x8 pa0,bf16x8 pa1,bf16x8 pa2,bf16x8 pa3){
  #pragma unroll
  for(int d0=0;d0<2;++d0){s16x4 lo[4],hi[4];
    #pragma unroll
    for(int ks=0;ks<4;++ks){
      asm volatile("ds_read_b64_tr_b16 %0,%1 offset:%c2":"=&v"(lo[ks]):"v"(vb),"i"(d0*4096+ks*1024):"memory");
      asm volatile("ds_read_b64_tr_b16 %0,%1 offset:%c2":"=&v"(hi[ks]):"v"(vb),"i"(d0*4096+ks*1024+512):"memory");}
    asm volatile("s_waitcnt lgkmcnt(0)":::"memory");SBAR();
    #define PK(k) (bf16x8){lo[k][0],lo[k][1],lo[k][2],lo[k][3],hi[k][0],hi[k][1],hi[k][2],hi[k][3]}
    o[d0]=__builtin_amdgcn_mfma_f32_32x32x16_bf16(pa0,PK(0),o[d0],0,0,0);
    o[d0]=__builtin_amdgcn_mfma_f32_32x32x16_bf16(pa1,PK(1),o[d0],0,0,0);
    o[d0]=__builtin_amdgcn_mfma_f32_32x32x16_bf16(pa2,PK(2),o[d0],0,0,0);
    o[d0]=__builtin_amdgcn_mfma_f32_32x32x16_bf16(pa3,PK(3),o[d0],0,0,0);
    #undef PK
  }
}

#ifndef ATTN_STORE16
#define ATTN_STORE16(p,v) (*(u32x4*)(p)=(v))
#endif
template<int THRL> __device__ __forceinline__ void attn_unit(int b,int h,int kvh,int qb,const bf16*Q,const bf16*__restrict__ K,const bf16*__restrict__ V,bf16*O,char*shm){
  int tid_o=threadIdx.x; asm volatile("":"+v"(tid_o)); const int tid=tid_o,lane=tid&63,r32=lane&31,hi=lane>>5; const int wid=__builtin_amdgcn_readfirstlane(tid>>6);
  const long rowbase=(long)b*SEQ; const int q0=qb*QB;
  const bf16*Qw=Q+(rowbase+q0+wid*QBLK)*QP+h*D;
  const bf16*Kh=K+rowbase*KVP+kvh*D,*Vh=V+rowbase*KVP+kvh*D;
  const unsigned lds0=(unsigned)(uintptr_t)shm;
  float*wsf=(float*)(shm+LDS_WS)+wid*64;
  const bf16*ksrc=Kh+(long)lane*KVP+wid*8;
  const bf16*vsrc=Vh+(long)(16*(wid&3)+(lane>>2))*KVP+(wid>>2)*32+(lane&3)*8;
  const unsigned kdst=lds0+LDS_K+wid*1024, vdst=lds0+LDS_V+wid*1024;
  #define DMA_K(t,slot) glds16(ksrc+(long)(t)*KVBLK*KVP,(unsigned)__builtin_amdgcn_readfirstlane(kdst+(slot)))
  #define DMA_V(t,slot) glds16(vsrc+(long)(t)*KVBLK*KVP,(unsigned)__builtin_amdgcn_readfirstlane(vdst+(slot)))
  const int vb0=(int)(lds0+LDS_V)+((lane>>4)&1)*32+(lane&3)*8+(4*hi+((lane&15)>>2))*64;
  const char*Kbase=shm+LDS_K; bf16x8 kf[8];
  const lds_cptr shm3=(lds_cptr)shm; const lds_cptr kp0=shm3+LDS_K+hi*1024+r32*16; const lds_cptr vp0=shm3+LDS_V+((lane>>4)&1)*32+(lane&3)*8+(4*hi+((lane&15)>>2))*64;
  const int NT=SEQ/KVBLK;
  DMA_K(0,0);DMA_V(0,0);DMA_K(1,SLOTB);
  bf16x8 qr[4];
  #pragma unroll
  for(int d0=0;d0<4;++d0)qr[d0]=*reinterpret_cast<const bf16x8*>(&Qw[(long)r32*QP+d0*16+hi*8]);
  float mhat=0.f,l_reg=0.f;f32x16 o[2];o[0]=f32x16{};o[1]=f32x16{};f32x16 negm=f32x16{};asm volatile("":"+v"(negm));
  #define CMASK(P0,P1,t) do{}while(0)
  bool resc=false;
  #define START(P0,P1) do{ const float rm=rowmax(P0,P1); resc=false; \
    { const float dl=rm; mhat=fadd_s(mhat,dl); \
      _Pragma("unroll") for(int r=0;r<16;++r){P0[r]=fsub_s(P0[r],dl);P1[r]=fsub_s(P1[r],dl);} \
      _Pragma("unroll") for(int r=0;r<16;++r)negm[r]=-mhat; asm volatile("":"+v"(negm)); } \
    _Pragma("unroll") for(int r=0;r<16;++r)P0[r]=__builtin_amdgcn_exp2f(P0[r]); }while(0)
  #define RESC() do{ if(resc){ asm volatile("s_waitcnt lgkmcnt(0)":::"memory"); \
      _Pragma("unroll") for(int d_=0;d_<2;++d_) _Pragma("unroll") for(int r=0;r<16;++r)o[d_][r]*=wsf[crow(r,hi)]; } }while(0)
  f32x16 pA0,pA1,pB0,pB1;
  int sl_prev=0,sl_cur=0,sl_next=SLOTB;
  #define ROT() do{sl_prev=sl_cur;sl_cur=sl_next;sl_next=(sl_next==(NSLOT-1)*SLOTB)?0:sl_next+SLOTB;}while(0)
  DMA_K(2,2*SLOTB);
  WAIT_BAR(3);
  qkt(pA0,pA1,Kbase,qr,negm,r32,hi);asm volatile("s_nop 15\n\ts_nop 7":"+v"(pA0),"+v"(pA1));CMASK(pA0,pA1,0);
  START(pA0,pA1);
  _Pragma("unroll") for(int r=0;r<16;++r)pA1[r]=__builtin_amdgcn_exp2f(pA1[r]);
  WAIT_BAR(0);
  DMA_K(3,0);DMA_V(1,SLOTB);
  ROT();
  kload8(kf,kp0+sl_cur);
  WAIT_BAR(2);
  s16x4 vlo[8],vhi[8]; u32x4 pw0,pw1,pw2,pw3;
  #define PKW(P,B) cvtpk_s(P[B],P[B+1])
  #define PAF(k) __builtin_bit_cast(bf16x8,pw##k)
  #define VFR(i) (bf16x8){vlo[i][0],vlo[i][1],vlo[i][2],vlo[i][3],vhi[i][0],vhi[i][1],vhi[i][2],vhi[i][3]}
  #define PIN(x) asm volatile("":"+v"(x))
  #define MX3(a,b,c) __builtin_fmaxf(__builtin_fmaxf((a),(b)),(c))
  #define GAPA(MF,A0,A1,A2,A3,W0,W1,PW) do{ MF; sacc+=A0; sacc+=A1; sacc+=A2; sacc+=A3; PIN(sacc); W0; W1; PIN(PW); SBAR(); }while(0)
  #define EX(v) __builtin_amdgcn_exp2f(v)
  #define GAPB(MF,X,B) do{ MF; X[B]=EX(X[B]); X[B+1]=EX(X[B+1]); X[B+2]=EX(X[B+2]); X[B+3]=EX(X[B+3]); PIN(X); SBAR(); }while(0)
  #define VRD(i) do{ vlo[i]=vtr(vp_+(((i)>>2)*4096+((i)&3)*1024)); vhi[i]=vtr(vp_+(((i)>>2)*4096+((i)&3)*1024+512)); }while(0)
  #define KRD(G,j) do{ if(G){ kload2(kf,kp0+sl_next,j); SBAR(); } }while(0)
  #define STEP(C0,C1,P0,P1,t,GK,GV,GL) do{ SBAR(); \
    const lds_cptr vp_=vp0+sl_prev; \
    VRD(0); SBAR(); float sacc=(P0[0]+P0[1]); \
    GAPA(C0=__builtin_amdgcn_mfma_f32_32x32x16_bf16(kf[0],qr[0],negm,0,0,0), P0[2],P0[3],P0[4],P0[5],     pw0[0]=PKW(P0,0), pw0[1]=PKW(P0,2), pw0); \
    VRD(4); SBAR(); GAPA(C1=__builtin_amdgcn_mfma_f32_32x32x16_bf16(kf[1],qr[0],negm,0,0,0), P0[6],P0[7],P0[8],P0[9],     pw0[2]=PKW(P0,4), pw0[3]=PKW(P0,6), pw0); \
    VRD(1); SBAR(); GAPA(C0=__builtin_amdgcn_mfma_f32_32x32x16_bf16(kf[2],qr[1],C0,0,0,0),   P0[10],P0[11],P0[12],P0[13], pw1[0]=PKW(P0,8), pw1[1]=PKW(P0,10), pw1); \
    VRD(5); SBAR(); GAPA(C1=__builtin_amdgcn_mfma_f32_32x32x16_bf16(kf[3],qr[1],C1,0,0,0),   P0[14],P0[15],P1[0],P1[1],   pw1[2]=PKW(P0,12),pw1[3]=PKW(P0,14), pw1); \
    VRD(2); SBAR(); GAPA(C0=__builtin_amdgcn_mfma_f32_32x32x16_bf16(kf[4],qr[2],C0,0,0,0),   P1[2],P1[3],P1[4],P1[5],     pw2[0]=PKW(P1,0), pw2[1]=PKW(P1,2), pw2); \
    VRD(6); SBAR(); GAPA(C1=__builtin_amdgcn_mfma_f32_32x32x16_bf16(kf[5],qr[2],C1,0,0,0),   P1[6],P1[7],P1[8],P1[9],     pw2[2]=PKW(P1,4), pw2[3]=PKW(P1,6), pw2); \
    VRD(3); SBAR(); GAPA(C0=__builtin_amdgcn_mfma_f32_32x32x16_bf16(kf[6],qr[3],C0,0,0,0),   P1[10],P1[11],P1[12],P1[13], pw3[0]=PKW(P1,8), pw3[1]=PKW(P1,10), pw3); \
    VRD(7); SBAR(); GAPA(C1=__builtin_amdgcn_mfma_f32_32x32x16_bf16(kf[7],qr[3],C1,0,0,0),   P1[14],P1[15],0.f,0.f,       pw3[2]=PKW(P1,12),pw3[3]=PKW(P1,14), pw3); \
    l_reg+=sacc; \
    if(GK){DMA_K((t)+3,sl_cur);} if(GV){DMA_V((t)+1,sl_next);} \
    CMASK(C0,C1,t); \
    { float a=MX3(C0[0],C0[1],C1[0]),b=MX3(C0[2],C0[3],C1[1]); a=MX3(a,C1[2],C1[3]); \
      _Pragma("unroll") for(int r=4;r<16;r+=4){a=MX3(a,C0[r],C0[r+1]);b=MX3(b,C0[r+2],C0[r+3]);a=MX3(a,C1[r],C1[r+1]);b=MX3(b,C1[r+2],C1[r+3]);} \
      float rm=__builtin_fmaxf(a,b); { auto rr=__builtin_amdgcn_permlane32_swap(__float_as_uint(rm),__float_as_uint(rm),false,false); rm=__builtin_fmaxf(__uint_as_float(rr[0]),__uint_as_float(rr[1])); } \
      resc=false; \
      if(__builtin_expect(__any(rm>(float)THRL),0)){ const float dl=__builtin_fmaxf(rm,0.f); mhat+=dl; \
        _Pragma("unroll") for(int r=0;r<16;++r){C0[r]-=dl;C1[r]-=dl;} \
        _Pragma("unroll") for(int r=0;r<16;++r)negm[r]=-mhat; asm volatile("":"+v"(negm)); \
        const float f=__builtin_amdgcn_exp2f(-dl); l_reg*=f; if(hi==0)wsf[r32]=f; resc=true; } } \
    SBAR(); \
    GAPB(o[0]=__builtin_amdgcn_mfma_f32_32x32x16_bf16(PAF(0),VFR(0),o[0],0,0,0), C0,0); \
    GAPB(o[1]=__builtin_amdgcn_mfma_f32_32x32x16_bf16(PAF(0),VFR(4),o[1],0,0,0), C0,4); \
    KRD(GL,0); GAPB(o[0]=__builtin_amdgcn_mfma_f32_32x32x16_bf16(PAF(1),VFR(1),o[0],0,0,0), C0,8); \
    KRD(GL,1); GAPB(o[1]=__builtin_amdgcn_mfma_f32_32x32x16_bf16(PAF(1),VFR(5),o[1],0,0,0), C0,12); \
    KRD(GL,2); GAPB(o[0]=__builtin_amdgcn_mfma_f32_32x32x16_bf16(PAF(2),VFR(2),o[0],0,0,0), C1,0); \
    KRD(GL,3); GAPB(o[1]=__builtin_amdgcn_mfma_f32_32x32x16_bf16(PAF(2),VFR(6),o[1],0,0,0), C1,4); \
    GAPB(o[0]=__builtin_amdgcn_mfma_f32_32x32x16_bf16(PAF(3),VFR(3),o[0],0,0,0), C1,8); \
    GAPB(o[1]=__builtin_amdgcn_mfma_f32_32x32x16_bf16(PAF(3),VFR(7),o[1],0,0,0), C1,12); \
    }while(0)
  int t=1;
  #undef CMASK
  #define CMASK(P0,P1,t) do{}while(0)
  for(;t+5<NT;t+=2){
    STEP(pB0,pB1,pA0,pA1,t,true,true,true);     WAIT_BAR(2); RESC(); ROT();
    STEP(pA0,pA1,pB0,pB1,t+1,true,true,true);   WAIT_BAR(2); RESC(); ROT();
  }
  #undef CMASK
  #define CMASK(P0,P1,t) do{}while(0)
  #define ENDW(tt) do{ if((tt)+3<NT){WAIT_BAR(2);} else if((tt)+2<NT){WAIT_BAR(1);} else {WAIT_BAR(0);} }while(0)
  for(;t+1<NT;t+=2){
    STEP(pB0,pB1,pA0,pA1,t,(t+3<NT),(t+1<NT),(t+1<NT));       ENDW(t);   RESC(); ROT();
    STEP(pA0,pA1,pB0,pB1,t+1,(t+4<NT),(t+2<NT),(t+2<NT));     ENDW(t+1); RESC(); ROT();
  }
  STEP(pB0,pB1,pA0,pA1,NT-1,false,false,false); RESC();
  { float sacc=pB0[0]+pB0[1]; _Pragma("unroll") for(int r=2;r<16;++r)sacc+=pB0[r]; _Pragma("unroll") for(int r=0;r<16;++r)sacc+=pB1[r]; l_reg+=sacc;
    pw0=(u32x4){PKW(pB0,0),PKW(pB0,2),PKW(pB0,4),PKW(pB0,6)};pw1=(u32x4){PKW(pB0,8),PKW(pB0,10),PKW(pB0,12),PKW(pB0,14)};pw2=(u32x4){PKW(pB1,0),PKW(pB1,2),PKW(pB1,4),PKW(pB1,6)};pw3=(u32x4){PKW(pB1,8),PKW(pB1,10),PKW(pB1,12),PKW(pB1,14)};
    SBAR(); pv(o,vb0+sl_cur,PAF(0),PAF(1),PAF(2),PAF(3)); }
  #undef PKW
  #undef PAF
  #undef VFR
  #undef PIN
  #undef MX3
  #undef GAPA
  #undef GAPB
  #undef EX
  #undef VRD
  #undef KRD
  #undef STEP
  #undef ENDW
  {auto rr=__builtin_amdgcn_permlane32_swap(__float_as_uint(l_reg),__float_as_uint(l_reg),false,false);l_reg=__uint_as_float(rr[0])+__uint_as_float(rr[1]);}
  if(hi==0)wsf[32+r32]=l_reg;asm volatile("s_waitcnt lgkmcnt(0)":::"memory");
  float rli[16];
  #pragma unroll
  for(int r=0;r<16;++r)rli[r]=__builtin_amdgcn_rcpf(wsf[32+crow(r,hi)]);
  bf16*Ow=O+(rowbase+q0+wid*QBLK)*OP+h*D;
  { bf16*stg=(bf16*)(shm+LDS_OST)+wid*2048;
    #pragma unroll
    for(int r=0;r<16;++r){const int orow=crow(r,hi);
      #pragma unroll
      for(int d0=0;d0<2;++d0)stg[orow*64+d0*32+r32]=__float2bfloat16(o[d0][r]*rli[r]);}
    asm volatile("s_waitcnt lgkmcnt(0)":::"memory");
    #pragma unroll
    for(int i=0;i<4;++i){const int row=i*8+(lane>>3),ch=lane&7; const u32x4 v=*(const u32x4*)(stg+row*64+ch*8); ATTN_STORE16(Ow+(long)row*OP+ch*8,v);} }
  asm volatile("s_waitcnt lgkmcnt(0)\n\ts_barrier":::"memory");
  #undef DMA_K
  #undef DMA_V
  #undef CMASK
  #undef START
  #undef RESC
  #undef ROT
}
constexpr int ATTN_LDS_BYTES=LDS_BYTES;
struct AttnTensors { const bf16* Q; const bf16* K; const bf16* V; bf16* O; };
template<int THRL=8> __device__ __forceinline__ void attn_phase(char*lds,const AttnTensors&T,int vcu,int G){
  for(int u=vcu;u<768;u+=G){ const int j=u&31,grp=(u>>5)&7,i=u>>8; const int b=grp>>2,kvh=grp&3,h=kvh*3+i;
    attn_unit<THRL>(b,h,kvh,j,T.Q,T.K,T.V,T.O,lds); }
}
#undef SBAR
#undef WAIT_BAR
}
constexpr int NWAVES = 8;
#ifndef MK_PER_PHASE
#define MK_PER_PHASE 0
#endif
constexpr int BATCH = 2, T = 8192, D = 1024, FF = 4096, DEPTH = 4, INW = 3584;
constexpr int M = BATCH * T;
constexpr int N_PHASES = 2 + 7 * DEPTH;
constexpr size_t MiB = 1u << 20;
constexpr size_t WS_SS = 1 * MiB;
constexpr size_t WS_W = 2 * MiB, W_LAYER_ELEMS = (size_t)27 * MiB / 2;
constexpr size_t WO_IN = 0, WO_AB = (size_t)INW * D, WO_OUT = WO_AB + (size_t)D * D, WO_UP = WO_OUT + (size_t)D * D, WO_DOWN = WO_UP + (size_t)FF * D;
static_assert(WO_DOWN + (size_t)D * FF == W_LAYER_ELEMS, "weight buffer");
constexpr size_t WS_XB = 56 * MiB;
constexpr size_t WS_Q = 88 * MiB, WS_K = 112 * MiB, WS_V = 120 * MiB, WS_F = 128 * MiB, WS_G = 136 * MiB, WS_AO = 200 * MiB, WS_YP = 232 * MiB, WS_END = 248 * MiB;
constexpr size_t WS_MG = WS_Q;
constexpr size_t WS_H = WS_Q;
static_assert(WS_H + (size_t)M * FF * 2 <= WS_YP, "h overlay");
constexpr int RING_BYTES = 131072, LDS_BYTES = 147456;
#define GAS __attribute__((address_space(1)))
#define LAS __attribute__((address_space(3)))
typedef unsigned short bf16;
typedef unsigned v4u __attribute__((ext_vector_type(4)));
typedef unsigned v2u __attribute__((ext_vector_type(2)));
typedef float f32x4 __attribute__((ext_vector_type(4)));
typedef short bf16x8 __attribute__((ext_vector_type(8)));
#define LDS_WAIT() asm volatile("s_waitcnt lgkmcnt(0)" ::: "memory")
__device__ __forceinline__ unsigned f2bf(float f) { unsigned u = __builtin_bit_cast(unsigned, f); return (u + 0x7fffu + ((u >> 16) & 1u)) >> 16; }
__device__ __forceinline__ unsigned pk2(float lo, float hi) { return f2bf(lo) | (f2bf(hi) << 16); }
__device__ __forceinline__ float wave_sum(float v) {
#pragma unroll
    for (int o = 1; o < 64; o <<= 1) v += __shfl_xor(v, o);
    return v;
}
__device__ __forceinline__ void transpose_item(const float* W, int ldw, const float* gain, bf16* WT, int ldt, int k0, int n0, int v0, int kcol0, LAS float* scr, int lane) {
    float wv[32];
#pragma unroll
    for (int i = 0; i < 32; ++i) wv[i] = W[(size_t)(k0 + 2 * i + (lane >> 5)) * ldw + n0 + (lane & 31)];
    if (gain) {
#pragma unroll
        for (int i = 0; i < 32; ++i) wv[i] *= gain[k0 + 2 * i + (lane >> 5)];
    }
#pragma unroll
    for (int i = 0; i < 32; ++i) scr[(2 * i + (lane >> 5)) * 33 + (lane & 31)] = wv[i];
    LDS_WAIT(); asm volatile("" ::: "memory");
    const int c = lane & 7;
#pragma unroll
    for (int j = 0; j < 4; ++j) { const int n = (lane >> 3) + 8 * j; const LAS float* s = scr + (8 * c) * 33 + n;
        v4u o; o.x = pk2(s[0 * 33], s[1 * 33]); o.y = pk2(s[2 * 33], s[3 * 33]); o.z = pk2(s[4 * 33], s[5 * 33]); o.w = pk2(s[6 * 33], s[7 * 33]);
        *(GAS v4u*)(WT + (size_t)(v0 + n) * ldt + kcol0 + k0 + 8 * c) = o; }
    LDS_WAIT(); asm volatile("" ::: "memory");
}
#define RLX_AGENT __ATOMIC_RELAXED, __HIP_MEMORY_SCOPE_AGENT

#define XB_TMO      128
#define XB_XCNT(j)  (256  + 64 * (j))
#define XB_XSUB(j)  (1280 + 64 * (j))
#define XB_XGEN(j)  (2304 + 64 * (j))
#define XB_TOP      3328
#define XB_TOPGEN   3392
#define XCD_BAR_WORDS 3456
#define XB_SPIN_CAP (1u << 18)

__device__ __forceinline__ unsigned xb_ld(unsigned* p)              { return __hip_atomic_load(p, __ATOMIC_RELAXED, __HIP_MEMORY_SCOPE_AGENT); }
__device__ __forceinline__ unsigned xb_add(unsigned* p, unsigned v) { return __hip_atomic_fetch_add(p, v, __ATOMIC_RELAXED, __HIP_MEMORY_SCOPE_AGENT); }
__device__ __forceinline__ unsigned xb_xcc_id() { return (unsigned)__builtin_amdgcn_s_getreg((3 << 11) | 20) & 0xFu; }
#define XB_SPIN(cond, bar) do { unsigned _sp = 0; while (cond) { __builtin_amdgcn_s_sleep(1); \
    if ((++_sp & 255u) == 0u) { if (xb_ld(&(bar)[XB_TMO])) break; if (_sp > XB_SPIN_CAP) { atomicAdd(&(bar)[XB_TMO], 1u); break; } } } } while (0)

struct XcdBarrier {
    unsigned* bar; unsigned x;
    volatile LAS unsigned* st;
};

__device__ __forceinline__ XcdBarrier xcd_barrier_post(unsigned* bar, volatile LAS unsigned* st) {
    XcdBarrier b; b.bar = bar; b.x = xb_xcc_id(); b.st = st;
    if (threadIdx.x == 0) (void)xb_add(&bar[XB_XCNT(b.x)], 1u);
    return b;
}
__device__ __forceinline__ void xcd_barrier_complete(unsigned* bar, unsigned x, unsigned& nloc, unsigned& nx) {
    const unsigned G = gridDim.x * gridDim.y * gridDim.z;
    unsigned sum, cnt, mine, sp = 0u;
    for (;;) {
        sum = 0u; cnt = 0u; mine = 0u;
#pragma unroll
        for (unsigned j = 0; j < 16; ++j) { const unsigned c = xb_ld(&bar[XB_XCNT(j)]); sum += c; cnt += (c > 0u) ? 1u : 0u; mine = (j == x) ? c : mine; }
        if (sum == G) break;
        __builtin_amdgcn_s_sleep(1);
        if ((++sp & 255u) == 0u) { if (xb_ld(&bar[XB_TMO])) break; if (sp > XB_SPIN_CAP) { atomicAdd(&bar[XB_TMO], 1u); break; } }
    }
    nloc = mine > 0u ? mine : 1u; nx = cnt > 0u ? cnt : 1u;
}

__device__ __forceinline__ void xcd_barrier(const XcdBarrier& b) {
    asm volatile("s_waitcnt vmcnt(0)" ::: "memory");
    __syncthreads();
    if (threadIdx.x == 0) {
        unsigned* bar = b.bar;
        __builtin_amdgcn_s_waitcnt(0);
        unsigned nloc = b.st[0], nx = b.st[1];
        if (nloc == 0u) { xcd_barrier_complete(bar, b.x, nloc, nx); b.st[0] = nloc; b.st[1] = nx; }
        const unsigned old = xb_add(&bar[XB_XSUB(b.x)], 1u);
        const unsigned gen = old / nloc;
        if (old + 1u == (gen + 1u) * nloc) {
            __builtin_amdgcn_fence(__ATOMIC_RELEASE, "agent");
            asm volatile("s_waitcnt vmcnt(0)" ::: "memory");
            const unsigned og = xb_add(&bar[XB_TOP], 1u);
            const unsigned tg = og / nx;
            if (og + 1u == (tg + 1u) * nx) xb_add(&bar[XB_TOPGEN], 1u);
            else XB_SPIN(xb_ld(&bar[XB_TOPGEN]) == tg, bar);
            __builtin_amdgcn_fence(__ATOMIC_ACQUIRE, "agent");
            xb_add(&bar[XB_XGEN(b.x)], 1u);
            asm volatile("s_waitcnt vmcnt(0)" ::: "memory");
        } else {
            XB_SPIN(xb_ld(&bar[XB_XGEN(b.x)]) == gen, bar);
            __builtin_amdgcn_fence(__ATOMIC_ACQUIRE, "agent");
            asm volatile("s_waitcnt vmcnt(0)" ::: "memory");
        }
    }
    __syncthreads();
}
constexpr int RSTD_OFF = RING_BYTES + 1024;
constexpr int MISC_OFF = RING_BYTES + 320;
constexpr size_t WS_GCNT = 131072;
constexpr size_t WS_CNT = 65536;
constexpr size_t WS_BAR = 16384;
constexpr size_t WS_XTAB = 163840;
__device__ __forceinline__ void group_barrier(unsigned* cnt, const unsigned* xtab, volatile LAS unsigned* same_xcc) {
    asm volatile("s_waitcnt vmcnt(0)" ::: "memory");
    __syncthreads();
    if (threadIdx.x == 0) {
        unsigned sx = *same_xcc;
        if (sx == 0u) { const unsigned g = blockIdx.x & 63u; const unsigned a = xb_ld((unsigned*)xtab + g), b = xb_ld((unsigned*)xtab + g + 64), c = xb_ld((unsigned*)xtab + g + 128), d = xb_ld((unsigned*)xtab + g + 192);
            sx = (a != 0u && a == b && b == c && c == d) ? 1u : 2u; *same_xcc = sx; }
        if (sx != 1u) { __builtin_amdgcn_fence(__ATOMIC_RELEASE, "agent"); asm volatile("s_waitcnt vmcnt(0)" ::: "memory"); }
        const unsigned old = xb_add(cnt, 1u), target = (old / 4u + 1u) * 4u; unsigned sp = 0;
        while (xb_ld(cnt) < target) { __builtin_amdgcn_s_sleep(1); if (++sp > (1u << 24)) break; }
        __builtin_amdgcn_fence(__ATOMIC_ACQUIRE, "agent"); asm volatile("s_waitcnt vmcnt(0)" ::: "memory");
    }
    __syncthreads();
}
struct Args { const float* in[13]; float* out; unsigned char* ws; int ph_lo, ph_hi; };
__device__ __forceinline__ void convert_layer(const __attribute__((address_space(4))) Args* a, int L, bf16* wbuf, LAS float* scr, int gw, int NGW, int lane, int part) {
    asm volatile("" : "+v"(lane));
    constexpr int I_IN = 16 * 112, I_A = 12 * 32, I_F = 4 * 32, I_O = 16 * 32, I_UP = 16 * 128, I_DN = 64 * 32, NITEMS = I_IN + I_A + I_F + I_O + I_UP + I_DN;
    const int it_lo = (part == 2) ? I_IN : 0, it_hi = (part == 1) ? I_IN : NITEMS;
    for (int it = it_lo + gw; it < it_hi; it += NGW) {
        int r = it;
        if (r < I_IN) { const int kb = r / 112, n0 = 32 * (r % 112); const int v0 = (n0 < 1024) ? (n0 & ~255) + 128 * ((n0 >> 5) & 1) + 32 * ((n0 >> 6) & 3) : n0;
            transpose_item(a->in[2] + (size_t)L * D * INW, INW, a->in[1] + L * D, wbuf + WO_IN, D, 64 * kb, n0, v0, 0, scr, lane); continue; } r -= I_IN;
        if (r < I_A) { transpose_item(a->in[6] + (size_t)L * 768 * D, D, nullptr, wbuf + WO_AB, D, 64 * (r / 32), 32 * (r % 32), 32 * (r % 32), 0, scr, lane); continue; } r -= I_A;
        if (r < I_F) { transpose_item(a->in[7] + (size_t)L * 256 * D, D, nullptr, wbuf + WO_AB, D, 64 * (r / 32), 32 * (r % 32), 32 * (r % 32), 768, scr, lane); continue; } r -= I_F;
        if (r < I_O) { transpose_item(a->in[8] + (size_t)L * D * D, D, nullptr, wbuf + WO_OUT, D, 64 * (r / 32), 32 * (r % 32), 32 * (r % 32), 0, scr, lane); continue; } r -= I_O;
        if (r < I_UP) { transpose_item(a->in[10] + (size_t)L * D * FF, FF, a->in[9] + L * D, wbuf + WO_UP, D, 64 * (r / 128), 32 * (r % 128), 32 * (r % 128), 0, scr, lane); continue; } r -= I_UP;
        transpose_item(a->in[11] + (size_t)L * FF * D, D, nullptr, wbuf + WO_DOWN, FF, 64 * (r / 32), 32 * (r % 32), 32 * (r % 32), 0, scr, lane);
    }
}
__device__ __forceinline__ unsigned short f2bf16(float f) { return (unsigned short)f2bf(f); }
#define MFMA16(a, b, c) __builtin_amdgcn_mfma_f32_16x16x32_bf16((a), (b), (c), 0, 0, 0)
__device__ __forceinline__ void fourier_a_phase(LAS unsigned char* lds, const bf16* Fb, bf16* Yp, int vcu, int G, int tid) {
    asm volatile("" : "+v"(tid));
    const int lane = tid & 63, w = __builtin_amdgcn_readfirstlane(tid >> 6), fr = lane & 15, fq = lane >> 4;
    constexpr int XS = 144, TS = 272, T_OFF = 128 * XS;
    bf16x8 w1[2], cb[4], sb[4];
    { const int n = 16 * w + fr, cp = n & 63; const bool isS = n >= 64;
#pragma unroll
      for (int ks = 0; ks < 2; ++ks)
#pragma unroll
        for (int e = 0; e < 8; ++e) { const int c = 32 * ks + 8 * fq + e; const float ph = (float)((cp * c) & 63) * (1.0f / 64.0f);
            w1[ks][e] = (short)f2bf16((isS ? __builtin_amdgcn_sinf(ph) : __builtin_amdgcn_cosf(ph)) * 0.125f); } }
    const int k1 = 16 * w + fr;
#pragma unroll
    for (int ks = 0; ks < 4; ++ks)
#pragma unroll
        for (int e = 0; e < 8; ++e) { const int r = 32 * ks + 8 * fq + e; const float ph = (float)((k1 * r) & 127) * (1.0f / 128.0f);
            cb[ks][e] = (short)f2bf16(__builtin_amdgcn_cosf(ph) * 0.08838834764831845f); sb[ks][e] = (short)f2bf16(__builtin_amdgcn_sinf(ph) * 0.08838834764831845f); }
    v4u xd[2];
#define FA_LOAD(IT) do { const int cc_ = (IT) & 63, g_ = ((IT) >> 6) & 3, b_ = (IT) >> 8; _Pragma("unroll") for (int i = 0; i < 2; ++i) { const int chunk = tid + 512 * i, r = chunk >> 3, ch = chunk & 7; \
        xd[i] = *(const GAS v4u*)(Fb + ((size_t)(b_ * 8192 + 64 * r + cc_) * 256 + g_ * 64 + ch * 8)); } } while (0)
#define FA_PUT() do { _Pragma("unroll") for (int i = 0; i < 2; ++i) { const int chunk = tid + 512 * i, r = chunk >> 3, ch = chunk & 7; *(LAS v4u*)(lds + r * XS + ch * 16) = xd[i]; } } while (0)
    if (vcu < 512) { FA_LOAD(vcu); FA_PUT(); }
    for (int it = vcu; it < 512; it += G) {
        const int cc = it & 63, g = (it >> 6) & 3, b = it >> 8;
        __syncthreads();
        f32x4 acc[8];
#pragma unroll
        for (int mt = 0; mt < 8; ++mt) { acc[mt] = (f32x4){0.f, 0.f, 0.f, 0.f};
#pragma unroll
            for (int ks = 0; ks < 2; ++ks) { const bf16x8 a = *(const LAS bf16x8*)(lds + (16 * mt + fr) * XS + (32 * ks + 8 * fq) * 2); acc[mt] = MFMA16(a, w1[ks], acc[mt]); } }
#pragma unroll
        for (int mt = 0; mt < 8; ++mt) { v2u o; o.x = pk2(acc[mt][0], acc[mt][1]); o.y = pk2(acc[mt][2], acc[mt][3]);
            *(LAS v2u*)(lds + T_OFF + (16 * w + fr) * TS + (16 * mt + 4 * fq) * 2) = o; }
        __syncthreads();
        if (it + G < 512) FA_LOAD(it + G);
        const float tph = (float)((k1 * cc) & 8191) * (1.0f / 8192.0f); const float tc = __builtin_amdgcn_cosf(tph), ts = __builtin_amdgcn_sinf(tph);
        bf16* yo = Yp + (((size_t)((b * 4 + g) * 128 + k1) * 2) * 64 + cc) * 64 + 4 * fq;
#pragma unroll
        for (int ct = 0; ct < 4; ++ct) { f32x4 p1 = (f32x4){0.f, 0.f, 0.f, 0.f}, p2 = p1, p34 = p1;
#pragma unroll
            for (int ks = 0; ks < 4; ++ks) {
                const bf16x8 aTc = *(const LAS bf16x8*)(lds + T_OFF + (16 * ct + fr) * TS + (32 * ks + 8 * fq) * 2);
                const bf16x8 aTs = *(const LAS bf16x8*)(lds + T_OFF + (64 + 16 * ct + fr) * TS + (32 * ks + 8 * fq) * 2);
                p1 = MFMA16(aTc, cb[ks], p1); p2 = MFMA16(aTs, sb[ks], p2); p34 = MFMA16(aTc, sb[ks], p34); p34 = MFMA16(aTs, cb[ks], p34); }
            const f32x4 yre = p1 - p2, yim = -p34; const f32x4 ore = yre * tc + yim * ts, oim = yim * tc - yre * ts;
            __hip_atomic_store((GAS unsigned long long*)(yo + 16 * ct), ((unsigned long long)pk2(ore[2], ore[3]) << 32) | pk2(ore[0], ore[1]), __ATOMIC_RELAXED, __HIP_MEMORY_SCOPE_AGENT);
            __hip_atomic_store((GAS unsigned long long*)(yo + 64 * 64 + 16 * ct), ((unsigned long long)pk2(oim[2], oim[3]) << 32) | pk2(oim[0], oim[1]), __ATOMIC_RELAXED, __HIP_MEMORY_SCOPE_AGENT); }
        if (it + G < 512) FA_PUT();
    }
    __syncthreads();
#undef FA_LOAD
#undef FA_PUT
}
__device__ __forceinline__ void fourier_b_phase(LAS unsigned char* lds, const bf16* Yp, bf16* AO, int vcu, int G, int tid) {
    asm volatile("" : "+v"(tid));
    const int lane = tid & 63, w = __builtin_amdgcn_readfirstlane(tid >> 6), fr = lane & 15, fq = lane >> 4, kt = w >> 1;
    constexpr int YS = 272;
    bf16x8 w2[4];
    const int k2 = 16 * kt + fr;
#pragma unroll
    for (int ks = 0; ks < 4; ++ks)
#pragma unroll
        for (int e = 0; e < 8; ++e) { const int K = 32 * ks + 8 * fq + e; const float ph = (float)((k2 * (K & 63)) & 63) * (1.0f / 64.0f);
            w2[ks][e] = (short)f2bf16((K >= 64 ? __builtin_amdgcn_sinf(ph) : __builtin_amdgcn_cosf(ph)) * 0.125f); }
    v4u yd[2];
#define FB_LOAD(IT) do { const bf16* src_ = Yp + (size_t)(((IT) >> 9) * 4 * 128 + (((IT) >> 7) & 3) * 128 + ((IT) & 127)) * 8192; _Pragma("unroll") for (int i = 0; i < 2; ++i) yd[i] = *(const GAS v4u*)(src_ + (size_t)(tid + 512 * i) * 8); } while (0)
    if (vcu < 1024) FB_LOAD(vcu);
    for (int it = vcu; it < 1024; it += G) {
        const int kk1 = it & 127, g = (it >> 7) & 3, b = it >> 9;
#pragma unroll
        for (int i = 0; i < 2; ++i) { const int chunk = tid + 512 * i, K = chunk >> 3, c0 = (chunk & 7) * 8;
            const v4u d = yd[i];
            LAS unsigned short* p = (LAS unsigned short*)(lds + c0 * YS + K * 2);
            p[0 * (YS / 2)] = (unsigned short)(d.x & 0xffffu); p[1 * (YS / 2)] = (unsigned short)(d.x >> 16); p[2 * (YS / 2)] = (unsigned short)(d.y & 0xffffu); p[3 * (YS / 2)] = (unsigned short)(d.y >> 16);
            p[4 * (YS / 2)] = (unsigned short)(d.z & 0xffffu); p[5 * (YS / 2)] = (unsigned short)(d.z >> 16); p[6 * (YS / 2)] = (unsigned short)(d.w & 0xffffu); p[7 * (YS / 2)] = (unsigned short)(d.w >> 16); }
        __syncthreads();
        if (it + G < 1024) FB_LOAD(it + G);
#pragma unroll
        for (int q = 0; q < 2; ++q) { const int ct = 2 * (w & 1) + q; f32x4 acc = (f32x4){0.f, 0.f, 0.f, 0.f};
#pragma unroll
            for (int ks = 0; ks < 4; ++ks) { const bf16x8 a = *(const LAS bf16x8*)(lds + (16 * ct + fr) * YS + (32 * ks + 8 * fq) * 2); acc = MFMA16(a, w2[ks], acc); }
            v2u o; o.x = pk2(acc[0], acc[1]); o.y = pk2(acc[2], acc[3]);
            *(GAS v2u*)(AO + (size_t)(b * 8192 + kk1 + 128 * k2) * 1024 + 768 + g * 64 + 16 * ct + 4 * fq) = o; }
        __syncthreads();
    }
#undef FB_LOAD
}

#define CAS __attribute__((address_space(4)))
#define PH_ARGS const CAS Args* ap = (const CAS Args*)__builtin_amdgcn_kernarg_segment_ptr(); asm volatile("" : "+s"(ap)); unsigned char* const ws = ap->ws; (void)ws
#define P_SS ((float*)(ws + WS_SS))
#define P_WB(l) ((bf16*)(ws + WS_W) + (size_t)((l) & 1) * W_LAYER_ELEMS)
#define P_XB ((bf16*)(ws + WS_XB))
#define P_Q ((bf16*)(ws + WS_Q))
#define P_K ((bf16*)(ws + WS_K))
#define P_V ((bf16*)(ws + WS_V))
#define P_F ((bf16*)(ws + WS_F))
#define P_G ((bf16*)(ws + WS_G))
#define P_AO ((bf16*)(ws + WS_AO))
#define P_YP ((bf16*)(ws + WS_YP))
#define P_MG ((bf16*)(ws + WS_MG))
#define P_H ((bf16*)(ws + WS_H))
__global__ void __launch_bounds__(NWAVES * 64, 2) fwd_kernel(Args args) {
    extern __shared__ __attribute__((aligned(16))) unsigned char lds_raw[];
    LAS unsigned char* lds = (LAS unsigned char*)lds_raw;
    cg::grid_group grid = cg::this_grid();
    const int G = gridDim.x; const int bx = blockIdx.x; const int vcu = (G % 8 == 0) ? (bx % 8) * (G / 8) + bx / 8 : bx;
    const int lo = args.ph_lo, hi = args.ph_hi;
    if (threadIdx.x < 32) ((volatile LAS unsigned*)(lds + MISC_OFF))[threadIdx.x] = 0u;
    __syncthreads();
    if (threadIdx.x == 0) __hip_atomic_store((unsigned*)(args.ws + WS_XTAB) + blockIdx.x, xb_xcc_id() + 1u, __ATOMIC_RELAXED, __HIP_MEMORY_SCOPE_AGENT);
#define IN(k) (lo <= (k) && (k) < hi)
#define GSEAM(k) do { if (IN(k) && IN((k) + 1)) { PH_ARGS; if (G == 256) group_barrier((unsigned*)(ws + WS_GCNT) + 64 * (bx & 63), (const unsigned*)(ws + WS_XTAB), (volatile LAS unsigned*)(lds + MISC_OFF) + 12); else { XcdBarrier xb_; xb_.bar = (unsigned*)(ws + WS_BAR); xb_.x = xb_xcc_id(); xb_.st = (volatile LAS unsigned*)(lds + MISC_OFF) + 8; xcd_barrier(xb_); } } } while (0)
#define SEAM(k) do { if (IN(k) && IN((k) + 1)) { PH_ARGS; XcdBarrier xb_; xb_.bar = (unsigned*)(ws + WS_BAR); xb_.x = xb_xcc_id(); xb_.st = (volatile LAS unsigned*)(lds + MISC_OFF) + 8; xcd_barrier(xb_); } } while (0)
#define WAVE_IDS int tid = threadIdx.x; asm volatile("" : "+v"(tid)); const int lane = tid & 63, wave = __builtin_amdgcn_readfirstlane(tid >> 6); const int gw = vcu * NWAVES + wave, NGW = G * NWAVES; (void)lane; (void)gw; (void)NGW
    if (IN(0)) {
        PH_ARGS; WAVE_IDS;
        convert_layer(ap, 0, P_WB(0), (LAS float*)(lds + 57344 + wave * 8448), gw, NGW, lane, 1);
        const float* x = ap->in[0]; float* SS = P_SS; bf16* XB = P_XB;
        for (int m = gw; m < M; m += 2 * NGW) {
            const int mb = (m + NGW < M) ? m + NGW : m;
            const GAS f32x4* xa = (const GAS f32x4*)(x + (size_t)m * D) + lane; const GAS f32x4* xc = (const GAS f32x4*)(x + (size_t)mb * D) + lane;
            f32x4 va[4], vb[4]; float sa = 0.f, sb = 0.f;
#pragma unroll
            for (int j = 0; j < 4; ++j) va[j] = xa[64 * j];
#pragma unroll
            for (int j = 0; j < 4; ++j) vb[j] = xc[64 * j];
#pragma unroll
            for (int j = 0; j < 4; ++j) { sa += pg8::hsum4(va[j] * va[j]); sb += pg8::hsum4(vb[j] * vb[j]); }
            sa = wave_sum(sa); sb = wave_sum(sb);
            GAS v2u* oa = (GAS v2u*)(XB + (size_t)m * D) + lane; GAS v2u* ob = (GAS v2u*)(XB + (size_t)mb * D) + lane;
#pragma unroll
            for (int j = 0; j < 4; ++j) { v2u o; o.x = pk2(va[j][0], va[j][1]); o.y = pk2(va[j][2], va[j][3]); oa[64 * j] = o; }
            if (lane < 16) SS[(size_t)m * 16 + lane] = (lane == 0) ? sa : 0.f;
            if (mb != m) {
#pragma unroll
                for (int j = 0; j < 4; ++j) { v2u o; o.x = pk2(vb[j][0], vb[j][1]); o.y = pk2(vb[j][2], vb[j][3]); ob[64 * j] = o; }
                if (lane < 16) SS[(size_t)mb * 16 + lane] = (lane == 0) ? sb : 0.f;
            }
        }
        if (blockIdx.x == 0) { unsigned* bw = (unsigned*)(ws + WS_BAR); for (int i = tid; i < XCD_BAR_WORDS; i += NWAVES * 64) bw[i] = 0u; }
        if (blockIdx.x == 0 && tid < DEPTH) ((unsigned*)(ws + WS_CNT))[64 * tid] = 0u;
        if (blockIdx.x == 0 && tid < 64) ((unsigned*)(ws + WS_GCNT))[64 * tid] = 0u;
    }
    if (IN(0) && IN(1)) {
        grid.sync();
        PH_ARGS; if (threadIdx.x == 0) (void)xb_add((unsigned*)(ws + WS_BAR) + XB_XCNT(xb_xcc_id()), 1u);
    }
#pragma unroll 1
    for (int l = 0; l < DEPTH; ++l) {
        const int pb = 1 + 7 * l;
        if (IN(pb)) {
            PH_ARGS;
            const pg8::PG8_LAS_F* rl = nullptr;
            if (G == 256) {
                const int pm_ = (bx & 7) * 8 + ((bx >> 3) & 7); const int t_ = threadIdx.x;
                if (t_ < 256) ((LAS float*)(lds + RSTD_OFF))[t_] = pg8::row_rstd(P_SS, pm_ * 256 + t_);
                __syncthreads(); rl = (const pg8::PG8_LAS_F*)(lds + RSTD_OFF);
            }
            pg8::Gemm g{P_XB, P_WB(l) + WO_IN, M, INW, D, D, D}; pg8::StaticOrder S; S.init(M, INW, G, bx);
            pg8::EpiInProj E{P_SS, P_Q, P_K, P_V, P_F, P_G, ap->in[4] + l * 64, ap->in[5] + l * 64, ap->in[3] + l * 2048, rl};
            pg8::gemm_phase<pg8::EpiInProj, pg8::StaticOrder, true, true>(lds, g, S, E);
            {
                WAVE_IDS; const int rem = ((M / 256) * (INW / 256)) % G;
                if (rem == 0) convert_layer(ap, l, P_WB(l), (LAS float*)(lds + 57344 + wave * 8448), gw, NGW, lane, 2);
                else if (bx >= rem) convert_layer(ap, l, P_WB(l), (LAS float*)(lds + 57344 + wave * 8448), (bx - rem) * NWAVES + wave, (G - rem) * NWAVES, lane, 2);
            }
        }
        SEAM(pb);
        if (IN(pb + 2)) {
            PH_ARGS; WAVE_IDS;
            unsigned* cnt = (unsigned*)(ws + WS_CNT) + 64 * l;
            fourier_a_phase(lds, P_F, P_YP, vcu, G, tid);
            asm volatile("s_waitcnt vmcnt(0)" ::: "memory"); __syncthreads();
            if (tid == 0) (void)xb_add(cnt, 1u);
            if (l + 1 < DEPTH) convert_layer(ap, l + 1, P_WB(l + 1), (LAS float*)(lds + 57344 + wave * 8448), gw, NGW, lane, 1);
            __syncthreads();
            const attn_body::AttnTensors AT{(const attn_body::bf16*)P_Q, (const attn_body::bf16*)P_K, (const attn_body::bf16*)P_V, (attn_body::bf16*)P_AO};
            attn_body::attn_phase<8>((char*)lds_raw, AT, vcu, G);
            if (tid == 0) { unsigned sp = 0; while (xb_ld(cnt) < (unsigned)G) { __builtin_amdgcn_s_sleep(2); if (++sp > (1u << 24)) break; }
                __builtin_amdgcn_fence(__ATOMIC_ACQUIRE, "agent"); asm volatile("s_waitcnt vmcnt(0)" ::: "memory"); }
            __syncthreads();
            fourier_b_phase(lds, P_YP, P_AO, vcu, G, tid);
        }
        SEAM(pb + 2);
        if (IN(pb + 3)) {
            PH_ARGS;
            pg8::Gemm g{P_AO, P_WB(l) + WO_AB, M, D, D, D, D}; pg8::StaticOrder S; S.init(M, D, G, bx);
            pg8::EpiBranchZ E{P_G, P_MG}; pg8::gemm_phase<pg8::EpiBranchZ, pg8::StaticOrder, true, true>(lds, g, S, E);
        }
        GSEAM(pb + 3);
        if (IN(pb + 4)) {
            PH_ARGS;
            pg8::Gemm g{P_MG, P_WB(l) + WO_OUT, M, D, D, D, D}; pg8::StaticOrder S; S.init(M, D, G, bx);
            pg8::EpiRes E{P_XB, P_SS}; pg8::gemm_phase<pg8::EpiRes, pg8::StaticOrder, true, true>(lds, g, S, E);
        }
        SEAM(pb + 4);
        if (IN(pb + 5)) {
            PH_ARGS;
            const pg8::PG8_LAS_F* rl = nullptr;
            if (G == 256) {
                const int pm_ = (bx & 7) * 8 + ((bx >> 3) & 7); const int t_ = threadIdx.x;
                if (t_ < 256) ((LAS float*)(lds + RSTD_OFF))[t_] = pg8::row_rstd(P_SS, pm_ * 256 + t_);
                __syncthreads(); rl = (const pg8::PG8_LAS_F*)(lds + RSTD_OFF);
            }
            pg8::Gemm g{P_XB, P_WB(l) + WO_UP, M, FF, D, D, D}; pg8::StaticOrder S; S.init(M, FF, G, bx);
            pg8::EpiUp E{P_SS, P_H, rl}; pg8::gemm_phase<pg8::EpiUp, pg8::StaticOrder, true, true>(lds, g, S, E);
        }
        GSEAM(pb + 5);
        if (IN(pb + 6)) {
            PH_ARGS;
            pg8::Gemm g{P_H, P_WB(l) + WO_DOWN, M, D, FF, FF, FF}; pg8::StaticOrder S; S.init(M, D, G, bx);
            if (l == DEPTH - 1 && G == 256 && IN(N_PHASES - 1)) {
                pg8::EpiResFinal E{P_XB, P_SS, ap->out, ap->in[12], (unsigned*)(ws + WS_GCNT) + 64 * (bx & 63), (pg8::PG8_LAS_F*)(lds + RSTD_OFF)};
                pg8::gemm_phase<pg8::EpiResFinal, pg8::StaticOrder, true, true>(lds, g, S, E);
            } else {
                pg8::EpiRes E{P_XB, P_SS}; pg8::gemm_phase<pg8::EpiRes, pg8::StaticOrder, true, true>(lds, g, S, E);
            }
        }
        if (!(l == DEPTH - 1 && G == 256)) SEAM(pb + 6);
    }
    if (IN(N_PHASES - 1) && G != 256) {
        PH_ARGS; WAVE_IDS;
        const float* gf = ap->in[12]; float* O = ap->out; const bf16* XBp = P_XB;
        f32x4 gv[2][2];
#pragma unroll
        for (int j = 0; j < 2; ++j) { gv[j][0] = *((const GAS f32x4*)gf + 2 * (lane + 64 * j)); gv[j][1] = *((const GAS f32x4*)gf + 2 * (lane + 64 * j) + 1); }
        for (int m = gw; m < M; m += 2 * NGW) {
            const int mb = (m + NGW < M) ? m + NGW : m;
            const GAS v4u* xa = (const GAS v4u*)(XBp + (size_t)m * D) + lane; const GAS v4u* xc = (const GAS v4u*)(XBp + (size_t)mb * D) + lane;
            v4u wa[2], wb[2];
#pragma unroll
            for (int j = 0; j < 2; ++j) { wa[j] = xa[64 * j]; wb[j] = xc[64 * j]; }
            f32x4 va[2][2], vb[2][2]; float sa = 0.f, sb = 0.f;
#pragma unroll
            for (int j = 0; j < 2; ++j) {
                va[j][0] = (f32x4){pg8::bf_lo(wa[j].x), pg8::bf_hi(wa[j].x), pg8::bf_lo(wa[j].y), pg8::bf_hi(wa[j].y)}; va[j][1] = (f32x4){pg8::bf_lo(wa[j].z), pg8::bf_hi(wa[j].z), pg8::bf_lo(wa[j].w), pg8::bf_hi(wa[j].w)};
                vb[j][0] = (f32x4){pg8::bf_lo(wb[j].x), pg8::bf_hi(wb[j].x), pg8::bf_lo(wb[j].y), pg8::bf_hi(wb[j].y)}; vb[j][1] = (f32x4){pg8::bf_lo(wb[j].z), pg8::bf_hi(wb[j].z), pg8::bf_lo(wb[j].w), pg8::bf_hi(wb[j].w)};
                sa += pg8::hsum4(va[j][0] * va[j][0]) + pg8::hsum4(va[j][1] * va[j][1]); sb += pg8::hsum4(vb[j][0] * vb[j][0]) + pg8::hsum4(vb[j][1] * vb[j][1]); }
            const float ra = rsqrtf(wave_sum(sa) * (1.0f / D) + 1e-6f), rb = rsqrtf(wave_sum(sb) * (1.0f / D) + 1e-6f);
            GAS f32x4* oa = (GAS f32x4*)(O + (size_t)m * D); GAS f32x4* ob = (GAS f32x4*)(O + (size_t)mb * D);
#pragma unroll
            for (int j = 0; j < 2; ++j) { oa[2 * (lane + 64 * j)] = va[j][0] * ra * gv[j][0]; oa[2 * (lane + 64 * j) + 1] = va[j][1] * ra * gv[j][1]; }
            if (mb != m) {
#pragma unroll
                for (int j = 0; j < 2; ++j) { ob[2 * (lane + 64 * j)] = vb[j][0] * rb * gv[j][0]; ob[2 * (lane + 64 * j) + 1] = vb[j][1] * rb * gv[j][1]; }
            }
        }
    }
#undef IN
#undef SEAM
}

extern "C" void kernel_launch(void* const* d_in, const int* in_sizes, int n_in, void* d_out, int out_size, void* d_ws, size_t ws_size, hipStream_t stream) {
    static int grid = 0;
    if (grid == 0) {
        if (n_in != 13 || in_sizes[0] != M * D || out_size != M * D || ws_size < WS_END) { fprintf(stderr, "kernel_launch: unexpected shapes (n_in %d, in0 %d, out %d, ws %zu)\n", n_in, n_in > 0 ? in_sizes[0] : -1, out_size, ws_size); grid = -1; return; }
        int dev = 0, cus = 0, per_cu = 0;
        if (hipGetDevice(&dev) != hipSuccess || hipDeviceGetAttribute(&cus, hipDeviceAttributeMultiprocessorCount, dev) != hipSuccess) { grid = -1; return; }
        if (hipFuncSetAttribute((const void*)fwd_kernel, hipFuncAttributeMaxDynamicSharedMemorySize, LDS_BYTES) != hipSuccess) { fprintf(stderr, "kernel_launch: hipFuncSetAttribute failed\n"); grid = -1; return; }
        if (hipOccupancyMaxActiveBlocksPerMultiprocessor(&per_cu, (const void*)fwd_kernel, NWAVES * 64, LDS_BYTES) != hipSuccess || per_cu < 1) per_cu = 1;
        (void)hipGetLastError();
        grid = cus * per_cu;
    }
    if (grid < 0) return;
    Args a{};
    for (int i = 0; i < 13; ++i) a.in[i] = (const float*)d_in[i];
    a.out = (float*)d_out; a.ws = (unsigned char*)d_ws;
#if MK_PER_PHASE
    for (int p = 0; p < N_PHASES; ++p) { a.ph_lo = p; a.ph_hi = p + 1; hipLaunchKernelGGL(fwd_kernel, dim3(grid), dim3(NWAVES * 64), LDS_BYTES, stream, a); }
#else
    a.ph_lo = 0; a.ph_hi = N_PHASES;
    void* kargs[] = {&a};
    const hipError_t e = hipLaunchCooperativeKernel((const void*)fwd_kernel, dim3(grid), dim3(NWAVES * 64), kargs, LDS_BYTES, stream);
    if (e != hipSuccess) fprintf(stderr, "kernel_launch: cooperative launch failed: %s (grid %d)\n", hipGetErrorString(e), grid);
#endif
}
```
